# Optimizing an MI355X kernel written in HIP

```python
import math
import jax, jax.numpy as jnp
from jax import lax
import numpy as np

D_MODEL = 1024
BATCH = 2
SEQ = 8192
DEPTH = 2

GRID_W = 64
CTX_LEN = 256
HEAD_DIM = 64
A_HEADS = 6
A_KV_HEADS = 2
A_GROUP = A_HEADS // A_KV_HEADS
WINDOW = 128
B_HEADS = 4
B_QK_DIM = 32
B_V_DIM = 2 * B_QK_DIM
C_HEADS = 6
C_Q_RANK = 256
C_KV_RANK = 128
C_NOPE = 64
C_ROPE = 32
C_V = 64
MIX_WIDTH = A_HEADS * HEAD_DIM + B_HEADS * B_V_DIM + C_HEADS * C_V
D_FF = 2816
Q_BLOCK = 128
ROPE_BASE = 10000.0
NORM_EPS = 1e-6
NEG_INF = -1e30
A_SCALE = HEAD_DIM ** -0.5
B_SCALE = B_QK_DIM ** -0.5
C_SCALE = (C_NOPE + C_ROPE) ** -0.5
IN_SPLITS = (A_HEADS * HEAD_DIM, A_KV_HEADS * HEAD_DIM, A_KV_HEADS * HEAD_DIM,
             B_HEADS * 2 * B_QK_DIM, B_HEADS * 2 * B_QK_DIM, B_HEADS * B_V_DIM,
             C_Q_RANK, C_KV_RANK, C_ROPE)
D_IN = (A_HEADS * HEAD_DIM + 2 * A_KV_HEADS * HEAD_DIM + 2 * B_HEADS * 2 * B_QK_DIM
        + B_HEADS * B_V_DIM + C_Q_RANK + C_KV_RANK + C_ROPE)

kernel_name = "hybrid_dit_parallel_head_groups"


def rms_norm(x, g):
    xf = x.astype(jnp.float32)
    y = xf * lax.rsqrt(jnp.mean(xf * xf, axis=-1, keepdims=True) + NORM_EPS)
    return (y * g.astype(jnp.float32)).astype(x.dtype)


def modulate(h, shift, scale):
    return h * (1 + scale) + shift


def _rope_1d(x, pos):
    r = x.shape[-1]
    freqs = ROPE_BASE ** (-jnp.arange(0, r, 2, dtype=jnp.float32) / r)
    ang = pos[:, None] * freqs[None, :]
    shape = (1, x.shape[1]) + (1,) * (x.ndim - 3) + (r // 2,)
    cos = jnp.cos(ang).reshape(shape)
    sin = jnp.sin(ang).reshape(shape)
    xf = x.astype(jnp.float32)
    x1, x2 = jnp.split(xf, 2, axis=-1)
    return jnp.concatenate([x1 * cos - x2 * sin, x2 * cos + x1 * sin], axis=-1).astype(x.dtype)


def axial_rope(x, row, col):
    half = x.shape[-1] // 2
    return jnp.concatenate([_rope_1d(x[..., :half], row), _rope_1d(x[..., half:], col)], axis=-1)


def split_in(p):
    outs = []
    start = 0
    for size in IN_SPLITS:
        outs.append(p[..., start:start + size])
        start += size
    return outs


def sweep_query_blocks(fn, q):
    B, n = q.shape[0], q.shape[1]
    nb = n // Q_BLOCK
    qb = jnp.moveaxis(q.reshape((B, nb, Q_BLOCK) + q.shape[2:]), 1, 0)
    out = jnp.moveaxis(lax.map(fn, qb), 0, 1)
    return out.reshape((B, n) + out.shape[3:])


def dense_attend(q, k, v, scale):
    s = jnp.einsum("bqhd,bkhd->bhqk", q, k).astype(jnp.float32) * scale
    p = jax.nn.softmax(s, axis=-1)
    return jnp.einsum("bhqk,bkhd->bqhd", p.astype(v.dtype), v)


def diff_attend(q, k, v, lam):
    s = jnp.einsum("bqhmd,bkhmd->bhmqk", q, k).astype(jnp.float32) * B_SCALE
    p = jax.nn.softmax(s, axis=-1)
    a = p[:, :, 0] - lam * p[:, :, 1]
    return jnp.einsum("bhqk,bkhd->bqhd", a.astype(v.dtype), v)


def windowed_gqa_latent(q, k, v, k_ctx, v_ctx, sink):
    B, S = q.shape[0], q.shape[1]
    nb = S // WINDOW
    qb = q.reshape(B, nb, WINDOW, A_KV_HEADS, A_GROUP, HEAD_DIM)
    pad = ((0, 0), (WINDOW, WINDOW), (0, 0), (0, 0))
    kp = jnp.pad(k, pad).reshape(B, nb + 2, WINDOW, A_KV_HEADS, HEAD_DIM)
    vp = jnp.pad(v, pad).reshape(B, nb + 2, WINDOW, A_KV_HEADS, HEAD_DIM)
    k_band = jnp.concatenate([kp[:, :-2], kp[:, 1:-1], kp[:, 2:]], axis=2)
    v_band = jnp.concatenate([vp[:, :-2], vp[:, 1:-1], vp[:, 2:]], axis=2)
    s_loc = jnp.einsum("bnqkgd,bnjkd->bnkgqj", qb, k_band).astype(jnp.float32) * A_SCALE
    qi = jnp.arange(WINDOW)
    kj = jnp.arange(3 * WINDOW)
    blk = jnp.arange(nb)
    offset = kj[None, :] - WINDOW - qi[:, None]
    key_pos = blk[:, None] * WINDOW - WINDOW + kj[None, :]
    mask = (jnp.abs(offset) <= WINDOW)[None] & ((key_pos >= 0) & (key_pos < S))[:, None, :]
    s_loc = jnp.where(mask[None, :, None, None], s_loc, NEG_INF)
    s_ctx = jnp.einsum("bnqkgd,bckd->bnkgqc", qb, k_ctx).astype(jnp.float32) * A_SCALE
    sink_col = jnp.broadcast_to(sink.astype(jnp.float32).reshape(1, 1, A_KV_HEADS, A_GROUP, 1, 1),
                                s_loc.shape[:-1] + (1,))
    p = jax.nn.softmax(jnp.concatenate([s_loc, s_ctx, sink_col], axis=-1), axis=-1).astype(v.dtype)
    n_loc = 3 * WINDOW
    n_ctx = k_ctx.shape[1]
    o = (jnp.einsum("bnkgqj,bnjkd->bnqkgd", p[..., :n_loc], v_band)
         + jnp.einsum("bnkgqc,bckd->bnqkgd", p[..., n_loc:n_loc + n_ctx], v_ctx))
    return o.reshape(B, S, A_HEADS * HEAD_DIM)


def gqa_context(q, k, v, sink):
    B, C = q.shape[0], q.shape[1]
    qg = q.reshape(B, C, A_KV_HEADS, A_GROUP, HEAD_DIM)
    s = jnp.einsum("bqkgd,bckd->bkgqc", qg, k).astype(jnp.float32) * A_SCALE
    sink_col = jnp.broadcast_to(sink.astype(jnp.float32).reshape(1, A_KV_HEADS, A_GROUP, 1, 1),
                                s.shape[:-1] + (1,))
    p = jax.nn.softmax(jnp.concatenate([s, sink_col], axis=-1), axis=-1).astype(v.dtype)
    o = jnp.einsum("bkgqc,bckd->bqkgd", p[..., :C], v)
    return o.reshape(B, C, A_HEADS * HEAD_DIM)


def mla_qkv(c_q, c_kv, k_r, q_norm, w_q_up, kv_norm, w_kv_up, row, col, use_rope):
    B, n = c_q.shape[0], c_q.shape[1]
    q = (rms_norm(c_q, q_norm) @ w_q_up).reshape(B, n, C_HEADS, C_NOPE + C_ROPE)
    q_nope, q_rope = q[..., :C_NOPE], q[..., C_NOPE:]
    kv = (rms_norm(c_kv, kv_norm) @ w_kv_up).reshape(B, n, C_HEADS, C_NOPE + C_V)
    k_nope, v = kv[..., :C_NOPE], kv[..., C_NOPE:]
    if use_rope:
        q_rope = axial_rope(q_rope, row, col)
        k_r = axial_rope(k_r, row, col)
    k = jnp.concatenate([k_nope, jnp.broadcast_to(k_r[:, :, None, :], (B, n, C_HEADS, C_ROPE))], axis=-1)
    q = jnp.concatenate([q_nope, q_rope], axis=-1)
    return q, k, v


def swiglu(h, w_gate, w_up, w_down):
    return (jax.nn.silu(h @ w_gate) * (h @ w_up)) @ w_down


def hybrid_layer(l, update_ctx, x, ctx, mod_x, mod_c, row, col,
                 g_pre_mix, g_post_mix, w_in, win_sink,
                 diff_lambda_q1, diff_lambda_k1, diff_lambda_q2, diff_lambda_k2, diff_sub_norm,
                 mla_q_norm, mla_w_q_up, mla_kv_norm, mla_w_kv_up,
                 w_out, g_pre_ffn, g_post_ffn, w_gate, w_up, w_down):
    B, S = x.shape[0], x.shape[1]
    C = ctx.shape[1]
    sh_m, sc_m, gt_m, sh_f, sc_f, gt_f = jnp.split(mod_x, 6, axis=-1)
    csh_m, csc_m, cgt_m, csh_f, csc_f, cgt_f = jnp.split(mod_c, 6, axis=-1)

    h_x = modulate(rms_norm(x, g_pre_mix), sh_m, sc_m)
    h_c = modulate(rms_norm(ctx, g_pre_mix), csh_m, csc_m)
    ax_q, ax_k, ax_v, dx_q, dx_k, dx_v, mx_q, mx_kv, mx_kr = split_in(h_x @ w_in)
    ac_q, ac_k, ac_v, dc_q, dc_k, dc_v, mc_q, mc_kv, mc_kr = split_in(h_c @ w_in)

    qa_x = axial_rope(ax_q.reshape(B, S, A_HEADS, HEAD_DIM), row, col)
    ka_x = axial_rope(ax_k.reshape(B, S, A_KV_HEADS, HEAD_DIM), row, col)
    va_x = ax_v.reshape(B, S, A_KV_HEADS, HEAD_DIM)
    ka_c = ac_k.reshape(B, C, A_KV_HEADS, HEAD_DIM)
    va_c = ac_v.reshape(B, C, A_KV_HEADS, HEAD_DIM)
    o_a = windowed_gqa_latent(qa_x, ka_x, va_x, ka_c, va_c, win_sink)

    lam_init = 0.8 - 0.6 * math.exp(-0.3 * l)
    lam = (jnp.exp(jnp.sum(diff_lambda_q1.astype(jnp.float32) * diff_lambda_k1.astype(jnp.float32)))
           - jnp.exp(jnp.sum(diff_lambda_q2.astype(jnp.float32) * diff_lambda_k2.astype(jnp.float32)))
           + lam_init)
    qd_x = axial_rope(dx_q.reshape(B, S, B_HEADS, 2, B_QK_DIM), row, col)
    kd_x = axial_rope(dx_k.reshape(B, S, B_HEADS, 2, B_QK_DIM), row, col)
    vd_x = dx_v.reshape(B, S, B_HEADS, B_V_DIM)
    kd_c = dc_k.reshape(B, C, B_HEADS, 2, B_QK_DIM)
    vd_c = dc_v.reshape(B, C, B_HEADS, B_V_DIM)
    kd_all = jnp.concatenate([kd_x, kd_c], axis=1)
    vd_all = jnp.concatenate([vd_x, vd_c], axis=1)
    o_b = sweep_query_blocks(lambda qb: diff_attend(qb, kd_all, vd_all, lam), qd_x)
    o_b = (rms_norm(o_b, diff_sub_norm) * (1.0 - lam_init)).reshape(B, S, B_HEADS * B_V_DIM)

    qm_x, km_x, vm_x = mla_qkv(mx_q, mx_kv, mx_kr, mla_q_norm, mla_w_q_up, mla_kv_norm, mla_w_kv_up,
                               row, col, True)
    qm_c, km_c, vm_c = mla_qkv(mc_q, mc_kv, mc_kr, mla_q_norm, mla_w_q_up, mla_kv_norm, mla_w_kv_up,
                               None, None, False)
    km_all = jnp.concatenate([km_x, km_c], axis=1)
    vm_all = jnp.concatenate([vm_x, vm_c], axis=1)
    o_c = sweep_query_blocks(lambda qb: dense_attend(qb, km_all, vm_all, C_SCALE), qm_x)
    o_c = o_c.reshape(B, S, C_HEADS * C_V)

    mix_x = jnp.concatenate([o_a, o_b, o_c], axis=-1) @ w_out
    x = x + gt_m * rms_norm(mix_x, g_post_mix)
    h = modulate(rms_norm(x, g_pre_ffn), sh_f, sc_f)
    x = x + gt_f * rms_norm(swiglu(h, w_gate, w_up, w_down), g_post_ffn)

    if update_ctx:
        o_a_c = gqa_context(ac_q.reshape(B, C, A_HEADS, HEAD_DIM), ka_c, va_c, win_sink)
        o_b_c = diff_attend(dc_q.reshape(B, C, B_HEADS, 2, B_QK_DIM), kd_c, vd_c, lam)
        o_b_c = (rms_norm(o_b_c, diff_sub_norm) * (1.0 - lam_init)).reshape(B, C, B_HEADS * B_V_DIM)
        o_c_c = dense_attend(qm_c, km_c, vm_c, C_SCALE).reshape(B, C, C_HEADS * C_V)
        mix_c = jnp.concatenate([o_a_c, o_b_c, o_c_c], axis=-1) @ w_out
        ctx = ctx + cgt_m * rms_norm(mix_c, g_post_mix)
        hc = modulate(rms_norm(ctx, g_pre_ffn), csh_f, csc_f)
        ctx = ctx + cgt_f * rms_norm(swiglu(hc, w_gate, w_up, w_down), g_post_ffn)
    return x, ctx


def setup_inputs(seed: int = 0) -> dict:
    key = jax.random.key(seed)
    ks = jax.random.split(key, 26)

    def normal(k, shape, scale):
        return scale * jax.random.normal(k, shape, jnp.float32)

    def gain(k, shape):
        return 1.0 + 0.05 * jax.random.normal(k, shape, jnp.float32)

    return {
        "x": normal(ks[0], (BATCH, SEQ, D_MODEL), 1.0),
        "c": normal(ks[1], (BATCH, D_MODEL), 1.0),
        "ctx": normal(ks[2], (BATCH, CTX_LEN, D_MODEL), 1.0),
        "c_ctx": normal(ks[3], (D_MODEL,), 1.0),
        "w_ada": normal(ks[4], (DEPTH, D_MODEL, 6 * D_MODEL), 0.5 * D_MODEL ** -0.5),
        "b_ada": normal(ks[5], (DEPTH, 6 * D_MODEL), 0.02),
        "g_pre_mix": gain(ks[6], (DEPTH, D_MODEL)),
        "g_post_mix": gain(ks[7], (DEPTH, D_MODEL)),
        "w_in": normal(ks[8], (DEPTH, D_MODEL, D_IN), D_MODEL ** -0.5),
        "win_sink": normal(ks[9], (DEPTH, A_HEADS), 0.5),
        "diff_lambda_q1": normal(ks[10], (DEPTH, B_QK_DIM), 0.1),
        "diff_lambda_k1": normal(ks[11], (DEPTH, B_QK_DIM), 0.1),
        "diff_lambda_q2": normal(ks[12], (DEPTH, B_QK_DIM), 0.1),
        "diff_lambda_k2": normal(ks[13], (DEPTH, B_QK_DIM), 0.1),
        "diff_sub_norm": gain(ks[14], (DEPTH, B_V_DIM)),
        "mla_q_norm": gain(ks[15], (DEPTH, C_Q_RANK)),
        "mla_w_q_up": normal(ks[16], (DEPTH, C_Q_RANK, C_HEADS * (C_NOPE + C_ROPE)), C_Q_RANK ** -0.5),
        "mla_kv_norm": gain(ks[17], (DEPTH, C_KV_RANK)),
        "mla_w_kv_up": normal(ks[18], (DEPTH, C_KV_RANK, C_HEADS * (C_NOPE + C_V)), C_KV_RANK ** -0.5),
        "w_out": normal(ks[19], (DEPTH, MIX_WIDTH, D_MODEL), MIX_WIDTH ** -0.5),
        "g_pre_ffn": gain(ks[20], (DEPTH, D_MODEL)),
        "g_post_ffn": gain(ks[21], (DEPTH, D_MODEL)),
        "w_gate": normal(ks[22], (DEPTH, D_MODEL, D_FF), D_MODEL ** -0.5),
        "w_up": normal(ks[23], (DEPTH, D_MODEL, D_FF), D_MODEL ** -0.5),
        "w_down": normal(ks[24], (DEPTH, D_FF, D_MODEL), D_FF ** -0.5),
    }


def reference(x, c, ctx, c_ctx, w_ada, b_ada, g_pre_mix, g_post_mix, w_in, win_sink,
              diff_lambda_q1, diff_lambda_k1, diff_lambda_q2, diff_lambda_k2, diff_sub_norm,
              mla_q_norm, mla_w_q_up, mla_kv_norm, mla_w_kv_up, w_out,
              g_pre_ffn, g_post_ffn, w_gate, w_up, w_down):
    n = x.shape[1]
    rows = n // GRID_W
    row = jnp.repeat(jnp.arange(rows, dtype=jnp.float32), GRID_W)
    col = jnp.tile(jnp.arange(GRID_W, dtype=jnp.float32), rows)
    for l in range(DEPTH):
        mod_x = (jax.nn.silu(c) @ w_ada[l] + b_ada[l])[:, None, :]
        mod_c = (jax.nn.silu(c_ctx) @ w_ada[l] + b_ada[l])[None, None, :]
        x, ctx = hybrid_layer(l, l < DEPTH - 1, x, ctx, mod_x, mod_c, row, col,
                              g_pre_mix[l], g_post_mix[l], w_in[l], win_sink[l],
                              diff_lambda_q1[l], diff_lambda_k1[l], diff_lambda_q2[l], diff_lambda_k2[l],
                              diff_sub_norm[l], mla_q_norm[l], mla_w_q_up[l], mla_kv_norm[l],
                              mla_w_kv_up[l], w_out[l], g_pre_ffn[l], g_post_ffn[l],
                              w_gate[l], w_up[l], w_down[l])
    return x
```

```cpp
#include <hip/hip_runtime.h>
#include <hip/hip_cooperative_groups.h>
#include <cstdio>
#include <cstdint>
#include <cstring>
namespace cg = cooperative_groups;

#define DI __device__ __forceinline__
typedef unsigned short bf16_t;
typedef short bf16x8 __attribute__((ext_vector_type(8)));
typedef float f32x16 __attribute__((ext_vector_type(16)));
typedef __bf16 bf16x2_t __attribute__((ext_vector_type(2)));
typedef float f32x2_t __attribute__((ext_vector_type(2)));
typedef unsigned u32x4 __attribute__((ext_vector_type(4)));

constexpr int SEQ = 8192, CTXL = 256, SP = SEQ + CTXL, NLAT = 2 * SEQ, NROW = NLAT + 2 * CTXL, DM = 1024, DFF = 2816;
constexpr int N_IN = 2048, N_GU = 2 * DFF, N_QUP = 768, N_KVUP = 768;
constexpr float LOG2E = 1.4426950408889634f;
constexpr float EPS = 1e-6f;
constexpr int NPHASE = 18;
constexpr int LDS_BYTES = 147456;
constexpr int HALF_LDS = 73728;
#ifndef PH_MASK
#define PH_MASK 0x3ff
#endif
#define PHON(k) ((PH_MASK >> (k)) & 1)
#ifndef REP_IN
#define REP_IN 1
#endif
#ifndef REP_UP
#define REP_UP 1
#endif
#ifndef REP_ATTN
#define REP_ATTN 1
#endif
#ifndef REP_OUT
#define REP_OUT 1
#endif
#ifndef REP_GU
#define REP_GU 1
#endif
#ifndef REP_DN
#define REP_DN 1
#endif

constexpr size_t al256(size_t x) { return (x + 255) / 256 * 256; }
constexpr size_t SZ_BT_IN = (size_t)N_IN * DM * 2, SZ_BT_OUT = (size_t)DM * DM * 2, SZ_BT_GU = (size_t)N_GU * DM * 2, SZ_BT_DN = (size_t)DM * DFF * 2;
constexpr size_t SZ_BT_QUP = (size_t)N_QUP * 256 * 2, SZ_BT_KVUP = (size_t)N_KVUP * 128 * 2;
constexpr size_t OFF_CTR = 0;
constexpr size_t OFF_LAM = 256;
constexpr size_t OFF_BAR = 512;
constexpr size_t OFF_ROPE = 512 + 3456 * 4;
constexpr size_t OFF_MOD = OFF_ROPE + 128 * 16 * 8;
constexpr size_t OFF_SSQ = al256(OFF_MOD + 2 * 3 * 6144 * 4);
constexpr size_t OFF_BT_IN = al256(OFF_SSQ + (size_t)2 * NROW * 2 * 4);
constexpr size_t OFF_BT_OUT = OFF_BT_IN + 2 * SZ_BT_IN;
constexpr size_t OFF_BT_GU = OFF_BT_OUT + 2 * SZ_BT_OUT;
constexpr size_t OFF_BT_DN = OFF_BT_GU + 2 * SZ_BT_GU;
constexpr size_t OFF_BT_QUP = OFF_BT_DN + 2 * SZ_BT_DN;
constexpr size_t OFF_BT_KVUP = OFF_BT_QUP + 2 * SZ_BT_QUP;
constexpr size_t OFF_XCTX = OFF_BT_KVUP + 2 * SZ_BT_KVUP;
constexpr size_t OFF_H = OFF_XCTX + (size_t)512 * DM * 4;
constexpr size_t OFF_BR = OFF_H + (size_t)NROW * DM * 2;
constexpr size_t SZ_Q64 = (size_t)SP * 64 * 2, SZ_Q96 = (size_t)SP * 96 * 2;
constexpr size_t OFF_QA = OFF_BR, OFF_KA = OFF_QA + 12 * SZ_Q64, OFF_VTA = OFF_KA + 4 * SZ_Q64, OFF_QB = OFF_VTA + 4 * SZ_Q64,
                 OFF_KB = OFF_QB + 8 * SZ_Q64, OFF_VTB = OFF_KB + 8 * SZ_Q64, OFF_QC = OFF_VTB + 8 * SZ_Q64, OFF_KC = OFF_QC + 12 * SZ_Q96,
                 OFF_VTC = OFF_KC + 12 * SZ_Q96, OFF_CQ = OFF_VTC + 12 * SZ_Q64, OFF_CKV = OFF_CQ + (size_t)NROW * 256 * 2,
                 OFF_ATT_END = OFF_CKV + (size_t)NROW * 128 * 2;
constexpr size_t OFF_G = OFF_BR;
constexpr size_t OFF_G_END = OFF_G + (size_t)NROW * DFF * 2;
constexpr size_t OFF_MIX = al256(OFF_G_END > OFF_ATT_END ? OFF_G_END : OFF_ATT_END);
constexpr size_t OFF_PART = OFF_MIX + (size_t)NROW * DM * 2;
constexpr size_t WS_NEED = OFF_MIX + (size_t)NROW * DM * 4;

struct Params {
    const float *x, *c, *ctx, *c_ctx, *w_ada, *b_ada, *g_pre_mix, *g_post_mix, *w_in, *win_sink, *lq1, *lk1, *lq2, *lk2, *sub_norm,
        *q_norm, *w_q_up, *kv_norm, *w_kv_up, *w_out, *g_pre_ffn, *g_post_ffn, *w_gate, *w_up, *w_down;
    float* out;
    char* ws;
    int ph_lo, ph_hi;
};

DI unsigned pk2(float a, float b) { f32x2_t v = {a, b}; bf16x2_t r = __builtin_convertvector(v, bf16x2_t); return __builtin_bit_cast(unsigned, r); }
DI bf16_t tobf(float a) { return (bf16_t)(pk2(a, 0.f) & 0xffffu); }
DI void st4(bf16_t* p, float a, float b, float c, float d) { *(uint2*)p = make_uint2(pk2(a, b), pk2(c, d)); }
DI int crow(int i, int h) { return (i & 3) + 8 * (i >> 2) + 4 * h; }
DI int perm16(int s) { return (s & ~12) | ((s & 4) << 1) | ((s & 8) >> 1); }
DI int perm32(int p) { return p < 8 ? p : (p < 16 ? p + 8 : (p < 24 ? p - 8 : p)); }
DI f32x16 mfma(bf16x8 a, bf16x8 b, f32x16 c) { return __builtin_amdgcn_mfma_f32_32x32x16_bf16(a, b, c, 0, 0, 0); }
DI bf16x8 pack8(const f32x16& x, int s) {
    uint4 w = make_uint4(pk2(x[8 * s + 0], x[8 * s + 1]), pk2(x[8 * s + 2], x[8 * s + 3]), pk2(x[8 * s + 4], x[8 * s + 5]), pk2(x[8 * s + 6], x[8 * s + 7]));
    return __builtin_bit_cast(bf16x8, w);
}
DI float silu(float x) { return x * __builtin_amdgcn_rcpf(1.f + __expf(-x)); }

struct RowInfo { int b, sp, prow, pcol; bool lat; };
DI RowInfo rowinfo(int r) {
    RowInfo ri;
    if (r < NLAT) { ri.lat = true; ri.b = r >> 13; int s = r & (SEQ - 1); ri.sp = s; ri.prow = s >> 6; ri.pcol = s & 63; }
    else { int c = r - NLAT; ri.lat = false; ri.b = c >> 8; ri.sp = SEQ + (c & 255); ri.prow = 0; ri.pcol = 0; }
    return ri;
}
DI void rope_a(f32x16& v, const float2* T, int pos, int h) {
#pragma unroll
    for (int i = 0; i < 8; ++i) { const float2 cs = T[pos * 16 + crow(i, h)]; const float x1 = v[i], x2 = v[i + 8]; v[i] = x1 * cs.x - x2 * cs.y; v[i + 8] = x2 * cs.x + x1 * cs.y; }
}
DI void rope_b(f32x16& v, const float2* T, int prow, int pcol, int h) {
#pragma unroll
    for (int i = 0; i < 8; ++i) { const int pos = i < 4 ? prow : pcol; const float2 cs = T[pos * 16 + 2 * ((i & 3) + 4 * h)];
        const float x1 = v[i], x2 = v[i + 8]; v[i] = x1 * cs.x - x2 * cs.y; v[i + 8] = x2 * cs.x + x1 * cs.y; }
}
DI void store16_bf(bf16_t* dst, const f32x16& v, int h, float sc) {
#pragma unroll
    for (int i4 = 0; i4 < 4; ++i4) st4(dst + 8 * i4 + 4 * h, v[4 * i4] * sc, v[4 * i4 + 1] * sc, v[4 * i4 + 2] * sc, v[4 * i4 + 3] * sc);
}
DI void store16_vt(bf16_t* vt_d0, const f32x16& v, int h, float sc, int spp) {
#pragma unroll
    for (int i = 0; i < 16; ++i) vt_d0[(size_t)crow(i, h) * SP + spp] = tobf(v[i] * sc);
}


#define XB_TMO      128
#define XB_XCNT(j)  (256  + 64 * (j))
#define XB_XSUB(j)  (1280 + 64 * (j))
#define XB_XGEN(j)  (2304 + 64 * (j))
#define XB_TOP      3328
#define XB_TOPGEN   3392
#define XCD_BAR_WORDS 3456
#define XB_SPIN_CAP (1u << 20)
#define LAS __attribute__((address_space(3)))
DI unsigned xb_ld(unsigned* p)              { return __hip_atomic_load(p, __ATOMIC_RELAXED, __HIP_MEMORY_SCOPE_AGENT); }
DI unsigned xb_add(unsigned* p, unsigned v) { return __hip_atomic_fetch_add(p, v, __ATOMIC_RELAXED, __HIP_MEMORY_SCOPE_AGENT); }
DI unsigned xb_xcc_id() { return (unsigned)__builtin_amdgcn_s_getreg((3 << 11) | 20) & 0xFu; }
#define XB_SPIN(cond, bar) do { unsigned _sp = 0; while (cond) { __builtin_amdgcn_s_sleep(1); \
    if ((++_sp & 255u) == 0u) { if (xb_ld(&(bar)[XB_TMO])) break; if (_sp > XB_SPIN_CAP) { atomicAdd(&(bar)[XB_TMO], 1u); break; } } } } while (0)
struct XcdBarrier { unsigned* bar; unsigned x; volatile LAS unsigned* st; };
DI XcdBarrier xcd_barrier_post(unsigned* bar, volatile LAS unsigned* st) {
    XcdBarrier b; b.bar = bar; b.x = xb_xcc_id(); b.st = st;
    if (threadIdx.x == 0) (void)xb_add(&bar[XB_XCNT(b.x)], 1u);
    return b;
}
DI void xcd_barrier_complete(unsigned* bar, unsigned x, unsigned& nloc, unsigned& nx) {
    const unsigned G = gridDim.x * gridDim.y * gridDim.z;
    unsigned sum, cnt, mine, sp = 0u;
    for (;;) {
        sum = 0u; cnt = 0u; mine = 0u;
#pragma unroll
        for (unsigned j = 0; j < 16; ++j) { const unsigned c = xb_ld(&bar[XB_XCNT(j)]); sum += c; cnt += (c > 0u) ? 1u : 0u; mine = (j == x) ? c : mine; }
        if (sum == G) break;
        __builtin_amdgcn_s_sleep(1);
        if ((++sp & 255u) == 0u) { if (xb_ld(&bar[XB_TMO])) break; if (sp > XB_SPIN_CAP) { atomicAdd(&bar[XB_TMO], 1u); break; } }
    }
    nloc = mine > 0u ? mine : 1u; nx = cnt > 0u ? cnt : 1u;
}
DI void xcd_barrier(const XcdBarrier& b) {
    asm volatile("s_waitcnt vmcnt(0)" ::: "memory");
    __syncthreads();
    if (threadIdx.x == 0) {
        unsigned* bar = b.bar;
        __builtin_amdgcn_s_waitcnt(0);
        unsigned nloc = b.st[0], nx = b.st[1];
        if (nloc == 0u) { xcd_barrier_complete(bar, b.x, nloc, nx); b.st[0] = nloc; b.st[1] = nx; }
        const unsigned old = xb_add(&bar[XB_XSUB(b.x)], 1u);
        const unsigned gen = old / nloc;
        if (old + 1u == (gen + 1u) * nloc) {
            __builtin_amdgcn_fence(__ATOMIC_RELEASE, "agent");
            asm volatile("s_waitcnt vmcnt(0)" ::: "memory");
            const unsigned og = xb_add(&bar[XB_TOP], 1u);
            const unsigned tg = og / nx;
            if (og + 1u == (tg + 1u) * nx) xb_add(&bar[XB_TOPGEN], 1u);
            else XB_SPIN(xb_ld(&bar[XB_TOPGEN]) == tg, bar);
            __builtin_amdgcn_fence(__ATOMIC_ACQUIRE, "agent");
            xb_add(&bar[XB_XGEN(b.x)], 1u);
            asm volatile("s_waitcnt vmcnt(0)" ::: "memory");
        } else {
            XB_SPIN(xb_ld(&bar[XB_XGEN(b.x)]) == gen, bar);
            __builtin_amdgcn_fence(__ATOMIC_ACQUIRE, "agent");
            asm volatile("s_waitcnt vmcnt(0)" ::: "memory");
        }
    }
    __syncthreads();
}

constexpr int LROW = 144;
constexpr int G_STAGE = 2 * 128 * LROW;

template <class Epi>
DI void gemm_tile(const bf16_t* __restrict__ A, int lda, const bf16_t* __restrict__ Bt, int ldb, int K, int m0, int n0, char* lds, const Epi& epi, const int tid) {
    const int lane = tid & 63, wid = tid >> 6, wm = wid >> 1, wn = wid & 1, l31 = lane & 31, h = lane >> 5;
    const int lrow = tid >> 3, lkc = tid & 7;
    const bf16_t* Ag = A + (size_t)(m0 + lrow) * lda + lkc * 8;
    const bf16_t* Bg = Bt + (size_t)(n0 + lrow) * ldb + lkc * 8;
    const size_t a32 = (size_t)32 * lda, b32 = (size_t)32 * ldb;
    const int lw = lrow * LROW + lkc * 16;
    u32x4 S0a0, S0a1, S0a2, S0a3, S0b0, S0b1, S0b2, S0b3, S1a0, S1a1, S1a2, S1a3, S1b0, S1b1, S1b2, S1b3, S2a0, S2a1, S2a2, S2a3, S2b0, S2b1, S2b2, S2b3;
    f32x16 acc[2][2];
#pragma unroll
    for (int i = 0; i < 2; ++i)
#pragma unroll
        for (int j = 0; j < 2; ++j)
#pragma unroll
            for (int e = 0; e < 16; ++e) acc[i][j][e] = 0.f;
    const int KT = K >> 6;
#define GLOAD(S, kt_) do { const bf16_t* ap_ = Ag + ((kt_) << 6); const bf16_t* bp_ = Bg + ((kt_) << 6); \
        S##a0 = *(const u32x4*)(ap_); S##a1 = *(const u32x4*)(ap_ + a32); S##a2 = *(const u32x4*)(ap_ + 2 * a32); S##a3 = *(const u32x4*)(ap_ + 3 * a32); \
        S##b0 = *(const u32x4*)(bp_); S##b1 = *(const u32x4*)(bp_ + b32); S##b2 = *(const u32x4*)(bp_ + 2 * b32); S##b3 = *(const u32x4*)(bp_ + 3 * b32); } while (0)
#define GWRITE(S, buf_) do { char* wb_ = lds + (buf_) * G_STAGE + lw; \
        *(u32x4*)(wb_) = S##a0; *(u32x4*)(wb_ + 32 * LROW) = S##a1; *(u32x4*)(wb_ + 64 * LROW) = S##a2; *(u32x4*)(wb_ + 96 * LROW) = S##a3; \
        *(u32x4*)(wb_ + 128 * LROW) = S##b0; *(u32x4*)(wb_ + 160 * LROW) = S##b1; *(u32x4*)(wb_ + 192 * LROW) = S##b2; *(u32x4*)(wb_ + 224 * LROW) = S##b3; } while (0)
    const int aoff = (wm * 64 + l31) * LROW + h * 16;
    const int boff = 128 * LROW + (wn * 64 + l31) * LROW + h * 16;
#define GCOMP(kt_) do { const char* base_ = lds + ((kt_) & 1) * G_STAGE; \
        _Pragma("unroll") for (int ks = 0; ks < 4; ++ks) { \
            const bf16x8 a0 = *(const bf16x8*)(base_ + aoff + ks * 32), a1 = *(const bf16x8*)(base_ + aoff + 32 * LROW + ks * 32); \
            const bf16x8 b0 = *(const bf16x8*)(base_ + boff + ks * 32), b1 = *(const bf16x8*)(base_ + boff + 32 * LROW + ks * 32); \
            acc[0][0] = mfma(b0, a0, acc[0][0]); acc[0][1] = mfma(b0, a1, acc[0][1]); \
            acc[1][0] = mfma(b1, a0, acc[1][0]); acc[1][1] = mfma(b1, a1, acc[1][1]); } } while (0)
#define GITER(kt_, SL, SW) do { if ((kt_) + 3 < KT) GLOAD(SL, (kt_) + 3); GCOMP(kt_); if ((kt_) + 1 < KT) GWRITE(SW, ((kt_) + 1) & 1); __syncthreads(); } while (0)
    GLOAD(S0, 0);
    if (KT > 1) GLOAD(S1, 1);
    if (KT > 2) GLOAD(S2, 2);
    GWRITE(S0, 0);
    __syncthreads();
    int kt = 0;
    for (; kt + 3 <= KT; kt += 3) { GITER(kt, S0, S1); GITER(kt + 1, S1, S2); GITER(kt + 2, S2, S0); }
    if (kt < KT) { GITER(kt, S0, S1); if (kt + 1 < KT) GITER(kt + 1, S1, S2); }
#undef GLOAD
#undef GWRITE
#undef GCOMP
#undef GITER
    epi(acc, m0 + wm * 64, n0 + wn * 64, lane);
}

DI bool tile_xcd(int i, int MT, int NT, int& mt, int& nt) {
    const int x = blockIdx.x & 7, slot = blockIdx.x >> 3, nslot = (gridDim.x + 7 - x) >> 3;
    const int cnt = (MT - x + 7) >> 3;
    const int j = slot + i * nslot;
    if (j >= cnt * NT) return false;
    const int per = 4 * NT, g = j / per, r = j - g * per, gm = (cnt - g * 4) < 4 ? (cnt - g * 4) : 4;
    nt = r / gm; mt = x + 8 * (g * 4 + (r - nt * gm));
    return true;
}

constexpr int G2_STAGE = 512 * LROW;
template <class Epi>
DI void gemm256(const bf16_t* __restrict__ A, int lda, const bf16_t* __restrict__ Bt, int ldb, int K, int m0, int n0, char* lds, const Epi& epi, const int tid) {
    const int lane = tid & 63, wid = tid >> 6, wm = wid >> 2, wn = wid & 3, l31 = lane & 31, h = lane >> 5;
    const int lrow = tid >> 3, lkc = tid & 7;
    const bf16_t* Ag = A + (size_t)(m0 + lrow) * lda + lkc * 8;
    const bf16_t* Bg = Bt + (size_t)(n0 + lrow) * ldb + lkc * 8;
    const size_t a64 = (size_t)64 * lda, b64 = (size_t)64 * ldb;
    const int lw = lrow * LROW + lkc * 16;
    u32x4 S0a0, S0a1, S0a2, S0a3, S0b0, S0b1, S0b2, S0b3;
    f32x16 acc[2][2][2];
#pragma unroll
    for (int a = 0; a < 2; ++a)
#pragma unroll
        for (int i = 0; i < 2; ++i)
#pragma unroll
            for (int j = 0; j < 2; ++j)
#pragma unroll
                for (int e = 0; e < 16; ++e) acc[a][i][j][e] = 0.f;
    const int KT = K >> 6;
#define GLOAD(S, kt_) do { const bf16_t* ap_ = Ag + ((kt_) << 6); const bf16_t* bp_ = Bg + ((kt_) << 6); \
        S##a0 = *(const u32x4*)(ap_); S##a1 = *(const u32x4*)(ap_ + a64); S##a2 = *(const u32x4*)(ap_ + 2 * a64); S##a3 = *(const u32x4*)(ap_ + 3 * a64); \
        S##b0 = *(const u32x4*)(bp_); S##b1 = *(const u32x4*)(bp_ + b64); S##b2 = *(const u32x4*)(bp_ + 2 * b64); S##b3 = *(const u32x4*)(bp_ + 3 * b64); } while (0)
#define GWRITE(S, buf_) do { char* wb_ = lds + (buf_) * G2_STAGE + lw; \
        *(u32x4*)(wb_) = S##a0; *(u32x4*)(wb_ + 64 * LROW) = S##a1; *(u32x4*)(wb_ + 128 * LROW) = S##a2; *(u32x4*)(wb_ + 192 * LROW) = S##a3; \
        *(u32x4*)(wb_ + 256 * LROW) = S##b0; *(u32x4*)(wb_ + 320 * LROW) = S##b1; *(u32x4*)(wb_ + 384 * LROW) = S##b2; *(u32x4*)(wb_ + 448 * LROW) = S##b3; } while (0)
    const int aoff = (wm * 128 + l31) * LROW + h * 16;
    const int boff = 256 * LROW + (wn * 64 + l31) * LROW + h * 16;
#define GCOMP1(kt_, ks0_) do { const char* base_ = lds + ((kt_) & 1) * G2_STAGE; \
        _Pragma("unroll") for (int ks = (ks0_); ks < (ks0_) + 1; ++ks) { \
            const bf16x8 a0 = *(const bf16x8*)(base_ + aoff + ks * 32), a1 = *(const bf16x8*)(base_ + aoff + 32 * LROW + ks * 32); \
            const bf16x8 a2 = *(const bf16x8*)(base_ + aoff + 64 * LROW + ks * 32), a3 = *(const bf16x8*)(base_ + aoff + 96 * LROW + ks * 32); \
            const bf16x8 b0 = *(const bf16x8*)(base_ + boff + ks * 32), b1 = *(const bf16x8*)(base_ + boff + 32 * LROW + ks * 32); \
            acc[0][0][0] = mfma(b0, a0, acc[0][0][0]); acc[0][0][1] = mfma(b0, a1, acc[0][0][1]); acc[1][0][0] = mfma(b0, a2, acc[1][0][0]); acc[1][0][1] = mfma(b0, a3, acc[1][0][1]); \
            acc[0][1][0] = mfma(b1, a0, acc[0][1][0]); acc[0][1][1] = mfma(b1, a1, acc[0][1][1]); acc[1][1][0] = mfma(b1, a2, acc[1][1][0]); acc[1][1][1] = mfma(b1, a3, acc[1][1][1]); } } while (0)
#define GWRITE_A(S, buf_) do { char* wb_ = lds + (buf_) * G2_STAGE + lw; \
        *(u32x4*)(wb_) = S##a0; *(u32x4*)(wb_ + 64 * LROW) = S##a1; *(u32x4*)(wb_ + 128 * LROW) = S##a2; *(u32x4*)(wb_ + 192 * LROW) = S##a3; } while (0)
#define GWRITE_B(S, buf_) do { char* wb_ = lds + (buf_) * G2_STAGE + lw; \
        *(u32x4*)(wb_ + 256 * LROW) = S##b0; *(u32x4*)(wb_ + 320 * LROW) = S##b1; *(u32x4*)(wb_ + 384 * LROW) = S##b2; *(u32x4*)(wb_ + 448 * LROW) = S##b3; } while (0)
#define GLOAD_A(S, kt_) do { const bf16_t* ap_ = Ag + ((kt_) << 6); \
        S##a0 = *(const u32x4*)(ap_); S##a1 = *(const u32x4*)(ap_ + a64); S##a2 = *(const u32x4*)(ap_ + 2 * a64); S##a3 = *(const u32x4*)(ap_ + 3 * a64); } while (0)
#define GLOAD_B(S, kt_) do { const bf16_t* bp_ = Bg + ((kt_) << 6); \
        S##b0 = *(const u32x4*)(bp_); S##b1 = *(const u32x4*)(bp_ + b64); S##b2 = *(const u32x4*)(bp_ + 2 * b64); S##b3 = *(const u32x4*)(bp_ + 3 * b64); } while (0)
#define GITER(kt_) do { GCOMP1(kt_, 0); __builtin_amdgcn_sched_barrier(0); if ((kt_) + 1 < KT) GWRITE_A(S0, ((kt_) + 1) & 1); \
        GCOMP1(kt_, 1); __builtin_amdgcn_sched_barrier(0); if ((kt_) + 1 < KT) GWRITE_B(S0, ((kt_) + 1) & 1); if ((kt_) + 2 < KT) GLOAD_A(S0, (kt_) + 2); \
        GCOMP1(kt_, 2); __builtin_amdgcn_sched_barrier(0); if ((kt_) + 2 < KT) GLOAD_B(S0, (kt_) + 2); \
        GCOMP1(kt_, 3); __syncthreads(); } while (0)
    GLOAD(S0, 0);
    GWRITE(S0, 0);
    if (KT > 1) GLOAD(S0, 1);
    __syncthreads();
    for (int kt = 0; kt < KT; ++kt) GITER(kt);
#undef GCOMP1
#undef GWRITE_A
#undef GWRITE_B
#undef GLOAD_A
#undef GLOAD_B
#undef GLOAD
#undef GWRITE
#undef GITER
    epi(acc[0], m0 + wm * 128, n0 + wn * 64, lane);
    epi(acc[1], m0 + wm * 128 + 64, n0 + wn * 64, lane);
}
DI void tile_mn(int t, int MT, int NT, int& mt, int& nt) {
    const int per = 8 * NT, g = t / per, r = t - g * per, gm = (MT - g * 8) < 8 ? (MT - g * 8) : 8;
    nt = r / gm; mt = g * 8 + (r - nt * gm);
}

struct EpiIn {
    char* ws; float* ssq; const float2* T; bool do_ssq;
    DI void operator()(f32x16 (&acc)[2][2], int mbase, int nbase, int lane) const {
        const int l31 = lane & 31, h = lane >> 5;
        bf16_t* QA = (bf16_t*)(ws + OFF_QA); bf16_t* KA = (bf16_t*)(ws + OFF_KA); bf16_t* VTA = (bf16_t*)(ws + OFF_VTA);
        bf16_t* QB = (bf16_t*)(ws + OFF_QB); bf16_t* KB = (bf16_t*)(ws + OFF_KB); bf16_t* VTB = (bf16_t*)(ws + OFF_VTB);
        bf16_t* KC = (bf16_t*)(ws + OFF_KC); bf16_t* CQ = (bf16_t*)(ws + OFF_CQ); bf16_t* CKV = (bf16_t*)(ws + OFF_CKV);
#pragma unroll
        for (int mt = 0; mt < 2; ++mt) {
            const int r = mbase + mt * 32 + l31;
            const RowInfo ri = rowinfo(r);
            const size_t sp = ri.sp; const int spp = perm16(ri.sp);
#pragma unroll
            for (int nt = 0; nt < 2; ++nt) {
                const int g = (nbase + nt * 32) >> 5;
                f32x16 v = acc[nt][mt];
                if (g < 16) {
                    const int half = g & 1;
                    if (ri.lat) rope_a(v, T, half ? ri.pcol : ri.prow, h);
                    if (g < 12) store16_bf(QA + ((size_t)(ri.b * 6 + (g >> 1)) * SP + sp) * 64 + half * 32, v, h, 0.125f * LOG2E);
                    else        store16_bf(KA + ((size_t)(ri.b * 2 + ((g - 12) >> 1)) * SP + sp) * 64 + half * 32, v, h, 1.f);
                } else if (g < 20) {
                    const int j = g - 16;
                    store16_vt(VTA + ((size_t)(ri.b * 2 + (j >> 1)) * 64 + (j & 1) * 32) * SP, v, h, 1.f, spp);
                } else if (g < 36) {
                    if (ri.lat) rope_b(v, T, ri.prow, ri.pcol, h);
                    if (g < 28) { const int j = g - 20; store16_bf(QB + ((size_t)(ri.b * 4 + (j >> 1)) * SP + sp) * 64 + (j & 1) * 32, v, h, 0.17677669529663687f * LOG2E); }
                    else        { const int j = g - 28; store16_bf(KB + ((size_t)(ri.b * 4 + (j >> 1)) * SP + sp) * 64 + (j & 1) * 32, v, h, 1.f); }
                } else if (g < 44) {
                    const int j = g - 36;
                    store16_vt(VTB + ((size_t)(ri.b * 4 + (j >> 1)) * 64 + (j & 1) * 32) * SP, v, h, 1.f, spp);
                } else if (g < 56) {
                    float s = 0.f;
#pragma unroll
                    for (int i = 0; i < 16; ++i) s += v[i] * v[i];
                    s += __shfl_xor(s, 32);
                    if (g < 52) { store16_bf(CQ + (size_t)r * 256 + (g - 44) * 32, v, h, 1.f); if (h == 0 && do_ssq) atomicAdd(ssq + (size_t)r * 2, s); }
                    else        { store16_bf(CKV + (size_t)r * 128 + (g - 52) * 32, v, h, 1.f); if (h == 0 && do_ssq) atomicAdd(ssq + (size_t)r * 2 + 1, s); }
                } else if (g == 56) {
                    if (ri.lat) rope_b(v, T, ri.prow, ri.pcol, h);
#pragma unroll
                    for (int hh = 0; hh < 6; ++hh) store16_bf(KC + ((size_t)(ri.b * 6 + hh) * SP + sp) * 96 + 64, v, h, 1.f);
                }
            }
        }
    }
};

struct EpiQup {
    char* ws; const float* ssq; const float2* T;
    DI void operator()(f32x16 (&acc)[2][2], int mbase, int nbase, int lane) const {
        const int l31 = lane & 31, h = lane >> 5;
        bf16_t* QC = (bf16_t*)(ws + OFF_QC);
#pragma unroll
        for (int mt = 0; mt < 2; ++mt) {
            const int r = mbase + mt * 32 + l31;
            const RowInfo ri = rowinfo(r);
            const float rstd = rsqrtf(ssq[(size_t)r * 2] * (1.f / 256.f) + EPS) * (0.10206207261596575f * LOG2E);
#pragma unroll
            for (int nt = 0; nt < 2; ++nt) {
                const int g = (nbase + nt * 32) >> 5;
                if (g >= 18) continue;
                f32x16 v = acc[nt][mt];
                const int head = g / 3, part = g - head * 3;
                if (part == 2 && ri.lat) rope_b(v, T, ri.prow, ri.pcol, h);
                store16_bf(QC + ((size_t)(ri.b * 6 + head) * SP + ri.sp) * 96 + part * 32, v, h, rstd);
            }
        }
    }
};
struct EpiKvup {
    char* ws; const float* ssq;
    DI void operator()(f32x16 (&acc)[2][2], int mbase, int nbase, int lane) const {
        const int l31 = lane & 31, h = lane >> 5;
        bf16_t* KC = (bf16_t*)(ws + OFF_KC); bf16_t* VTC = (bf16_t*)(ws + OFF_VTC);
#pragma unroll
        for (int mt = 0; mt < 2; ++mt) {
            const int r = mbase + mt * 32 + l31;
            const RowInfo ri = rowinfo(r);
            const float rstd = rsqrtf(ssq[(size_t)r * 2 + 1] * (1.f / 128.f) + EPS);
            const int spp = perm16(ri.sp);
#pragma unroll
            for (int nt = 0; nt < 2; ++nt) {
                const int g = (nbase + nt * 32) >> 5;
                const f32x16 v = acc[nt][mt];
                if (g < 12) store16_bf(KC + ((size_t)(ri.b * 6 + (g >> 1)) * SP + ri.sp) * 96 + (g & 1) * 32, v, h, rstd);
                else { const int j = g - 12; store16_vt(VTC + ((size_t)(ri.b * 6 + (j >> 1)) * 64 + (j & 1) * 32) * SP, v, h, rstd, spp); }
            }
        }
    }
};
struct EpiF32 {
    bf16_t* O;
    DI void operator()(f32x16 (&acc)[2][2], int mbase, int nbase, int lane) const {
        const int l31 = lane & 31, h = lane >> 5;
#pragma unroll
        for (int mt = 0; mt < 2; ++mt) {
            bf16_t* rowp = O + (size_t)(mbase + mt * 32 + l31) * DM + nbase;
#pragma unroll
            for (int nt = 0; nt < 2; ++nt) store16_bf(rowp + nt * 32, acc[nt][mt], h, 1.f);
        }
    }
};
struct EpiGU {
    bf16_t* G;
    DI void operator()(f32x16 (&acc)[2][2], int mbase, int nbase, int lane) const {
        const int l31 = lane & 31, h = lane >> 5;
#pragma unroll
        for (int mt = 0; mt < 2; ++mt) {
            bf16_t* rowp = G + (size_t)(mbase + mt * 32 + l31) * DFF + (nbase >> 1);
            f32x16 v;
#pragma unroll
            for (int i = 0; i < 16; ++i) v[i] = silu(acc[0][mt][i]) * acc[1][mt][i];
            store16_bf(rowp, v, h, 1.f);
        }
    }
};

DI int imax3(int a, int b, int c) { return max(max(a, b), c); }
template <int KW, int DKQ>
DI void attn_tile(const char* kb, const char* vb, const bf16x8 (&qf)[DKQ / 16], int koff, bool domask, int kq0, bool first,
                  f32x16 (&o)[2], float& mref, float& l, int l31, int h) {
    constexpr int KROW = (KW + 8) * 2, NQ = DKQ / 16;
    f32x16 s0, s1;
    bf16x8 kf0[NQ], kf1[NQ];
#pragma unroll
    for (int st = 0; st < NQ; ++st) {
        kf0[st] = *(const bf16x8*)(kb + l31 * KROW + (koff + st * 16 + h * 8) * 2);
        kf1[st] = *(const bf16x8*)(kb + (32 + l31) * KROW + (koff + st * 16 + h * 8) * 2);
    }
    const float nm = -mref;
#pragma unroll
    for (int e = 0; e < 16; ++e) { s0[e] = nm; s1[e] = nm; }
    __builtin_amdgcn_sched_barrier(0);
#pragma unroll
    for (int st = 0; st < NQ; ++st) { s0 = mfma(kf0[st], qf[st], s0); s1 = mfma(kf1[st], qf[st], s1); }
    bf16x8 vf[2][4];
#pragma unroll
    for (int db = 0; db < 2; ++db)
#pragma unroll
        for (int kk = 0; kk < 4; ++kk) vf[db][kk] = *(const bf16x8*)(vb + (db * 32 + l31) * LROW + (kk * 16 + h * 8) * 2);
    __builtin_amdgcn_sched_barrier(0);
    if (domask) {
#pragma unroll
        for (int i = 0; i < 16; ++i) {
            const int d0 = kq0 + crow(i, h), d1 = d0 + 32;
            s0[i] = (d0 > 128 || d0 < -128) ? -1e30f : s0[i];
            s1[i] = (d1 > 128 || d1 < -128) ? -1e30f : s1[i];
        }
    }
    int mi = imax3(__float_as_int(s0[0]), __float_as_int(s0[1]), __float_as_int(s1[0]));
    mi = max(mi, __float_as_int(s1[1]));
#pragma unroll
    for (int i = 2; i < 16; i += 2) { mi = imax3(mi, __float_as_int(s0[i]), __float_as_int(s0[i + 1])); mi = imax3(mi, __float_as_int(s1[i]), __float_as_int(s1[i + 1])); }
    mi = max(mi, __shfl_xor(mi, 32));
    if (__any(first || mi > 0x41000000)) {
        float mx = fmaxf(s0[0], s1[0]);
#pragma unroll
        for (int i = 1; i < 16; ++i) mx = fmaxf(mx, fmaxf(s0[i], s1[i]));
        mx = fmaxf(mx, __shfl_xor(mx, 32));
        const float d = first ? mx : fmaxf(mx, 0.f);
        mref += d;
        const float alpha = first ? 1.f : __builtin_amdgcn_exp2f(-d);
        l *= alpha;
#pragma unroll
        for (int e = 0; e < 16; ++e) { o[0][e] *= alpha; o[1][e] *= alpha; s0[e] -= d; s1[e] -= d; }
    }
    float ps0 = 0.f, ps1 = 0.f;
#pragma unroll
    for (int i = 0; i < 16; ++i) { s0[i] = __builtin_amdgcn_exp2f(s0[i]); s1[i] = __builtin_amdgcn_exp2f(s1[i]); ps0 += s0[i]; ps1 += s1[i]; }
    l += ps0 + ps1;
    bf16x8 pf[4];
    pf[0] = pack8(s0, 0); pf[1] = pack8(s0, 1); pf[2] = pack8(s1, 0); pf[3] = pack8(s1, 1);
#pragma unroll
    for (int db = 0; db < 2; ++db)
#pragma unroll
        for (int kk = 0; kk < 4; ++kk) o[db] = mfma(vf[db][kk], pf[kk], o[db]);
}

template <int KW, int DKQ>
DI void attn_loop(const bf16_t* __restrict__ Qg, const bf16_t* __restrict__ Kg, const bf16_t* __restrict__ Vg, int qrow, int koff,
                  int r0a, int n0, int r1a, int n1, bool mask, int qpos, bool has_ref, char* lds, f32x16 (&o)[2], float& mref, float& l, const int tid) {
    constexpr int KROW = (KW + 8) * 2, KT_BYTES = 64 * KROW, VT_BYTES = 64 * LROW, STAGE = KT_BYTES + VT_BYTES, NKC = KW / 8, NQ = DKQ / 16;
    constexpr bool K2 = (64 * NKC) > 512;
    const int lane = tid & 63, l31 = lane & 31, h = lane >> 5;
    bf16x8 qf[NQ];
#pragma unroll
    for (int st = 0; st < NQ; ++st) qf[st] = *(const bf16x8*)(Qg + (size_t)(qrow + l31) * KW + koff + st * 16 + h * 8);
    const int c0 = tid, row0 = c0 / NKC, kc0 = c0 - row0 * NKC, kgo0 = row0 * KW + kc0 * 8, klo0 = row0 * KROW + kc0 * 16;
    const int c1 = tid + 512, row1 = c1 / NKC, kc1 = c1 - row1 * NKC, kgo1 = row1 * KW + kc1 * 8, klo1 = row1 * KROW + kc1 * 16;
    const bool has2 = K2 && tid < 64 * NKC - 512;
    const int vrow = tid >> 3, vkc = tid & 7;
    const bf16_t* Vg0 = Vg + (size_t)vrow * SP + vkc * 8;
    const int vlo = KT_BYTES + vrow * LROW + vkc * 16;
    u32x4 Ak0, Ak1 = {0u, 0u, 0u, 0u}, Av0, Bk0, Bk1 = {0u, 0u, 0u, 0u}, Bv0;
    const int NT = n0 + n1;
#define AKEY(t_) ((t_) < n0 ? r0a + 64 * (t_) : r1a + 64 * ((t_) - n0))
#define ALOAD(S, key0_) do { const bf16_t* kp_ = Kg + (size_t)(key0_) * KW; S##k0 = *(const u32x4*)(kp_ + kgo0); if (K2) { if (has2) S##k1 = *(const u32x4*)(kp_ + kgo1); } \
        S##v0 = *(const u32x4*)(Vg0 + (key0_)); } while (0)
#define AWRITE(S, wb_) do { *(u32x4*)((wb_) + klo0) = S##k0; if (K2) { if (has2) *(u32x4*)((wb_) + klo1) = S##k1; } *(u32x4*)((wb_) + vlo) = S##v0; } while (0)
#define AITER(t_, SL, SW) do { const int key0_t = AKEY(t_); if ((t_) + 2 < NT) { const int kn_ = AKEY((t_) + 2); ALOAD(SL, kn_); } \
        const char* kb_ = lds + ((t_) & 1) * STAGE; \
        attn_tile<KW, DKQ>(kb_, kb_ + KT_BYTES, qf, koff, mask && key0_t < SEQ, key0_t - qpos, (t_) == 0 && !has_ref, o, mref, l, l31, h); \
        if ((t_) + 1 < NT) { char* wb_ = lds + (((t_) + 1) & 1) * STAGE; AWRITE(SW, wb_); } __syncthreads(); } while (0)
    { const int k0_ = AKEY(0); ALOAD(A, k0_); }
    if (NT > 1) { const int k1_ = AKEY(1); ALOAD(B, k1_); }
    AWRITE(A, lds);
    __syncthreads();
    int t = 0;
    for (; t + 2 <= NT; t += 2) { AITER(t, A, B); AITER(t + 1, B, A); }
    if (t < NT) AITER(t, A, B);
#undef AKEY
#undef ALOAD
#undef AWRITE
#undef AITER
}

DI void zero_o(f32x16 (&o)[2]) {
#pragma unroll
    for (int e = 0; e < 16; ++e) { o[0][e] = 0.f; o[1][e] = 0.f; }
}
DI void store_o(bf16_t* dst, const f32x16 (&o)[2], int h, float inv) { store16_bf(dst, o[0], h, inv); store16_bf(dst + 32, o[1], h, inv); }

constexpr int U_C = 384, U_B = 512, U_A = 384, U_LAT = U_C + U_B + U_A, U_CC = 12, U_BC = 16, U_AC = 12;
#ifndef ATT_MASK
#define ATT_MASK 7
#endif
#define RELANE() int tid2 = threadIdx.x; asm volatile("" : "+v"(tid2)); const int lane = tid2 & 63, wid = tid2 >> 6, l31 = lane & 31, h = lane >> 5; (void)wid; (void)l31; (void)h
DI void attn_unit(const Params& p, char* ws, int layer, int u, char* lds, const int tid) {
    bf16_t* OCAT = (bf16_t*)(ws + OFF_H);
    int type, b, head, qrow_blk, ctxq = 0;
    if (u < U_C) { type = 2; b = u / 192; const int r = u % 192; head = r >> 5; qrow_blk = (r & 31) * 256; }
    else if (u < U_C + U_B) { const int v = u - U_C; type = 1; b = v >> 8; const int r = v & 255; head = r >> 6; qrow_blk = (r & 63) * 128; }
    else if (u < U_LAT) { const int v = u - U_C - U_B; type = 0; b = v / 192; const int r = v % 192; head = r >> 5; qrow_blk = (r & 31) * 256; }
    else if (u < U_LAT + U_CC) { const int v = u - U_LAT; type = 2; ctxq = 1; b = v / 6; head = v % 6; qrow_blk = SEQ; }
    else if (u < U_LAT + U_CC + U_BC) { const int v = u - U_LAT - U_CC; type = 1; ctxq = 1; b = v >> 3; const int r = v & 7; head = r >> 1; qrow_blk = SEQ + (r & 1) * 128; }
    else { const int v = u - U_LAT - U_CC - U_BC; type = 0; ctxq = 1; b = v / 6; head = v % 6; qrow_blk = SEQ; }

    if (type == 1) { if (ATT_MASK & 2) {
        f32x16 o[2]; zero_o(o);
        float m = 0.f, l = 0.f;
        const bf16_t* Qg = (const bf16_t*)(ws + OFF_QB) + (size_t)(b * 4 + head) * SP * 64;
        const bf16_t* Kg = (const bf16_t*)(ws + OFF_KB) + (size_t)(b * 4 + head) * SP * 64;
        const bf16_t* Vg = (const bf16_t*)(ws + OFF_VTB) + (size_t)(b * 4 + head) * 64 * SP;
        attn_loop<64, 32>(Qg, Kg, Vg, qrow_blk + ((tid >> 6) & 3) * 32, (tid >> 8) * 32, ctxq ? SEQ : 0, ctxq ? 4 : SP / 64, 0, 0, false, 0, false, lds, o, m, l, tid);
        RELANE();
        const float lt = l + __shfl_xor(l, 32), inv = 1.f / lt;
        float* xb = (float*)lds;
        if (wid >= 4) {
#pragma unroll
            for (int db = 0; db < 2; ++db)
#pragma unroll
                for (int i = 0; i < 16; ++i) xb[((wid - 4) * 32 + db * 16 + i) * 64 + lane] = o[db][i] * inv;
        }
        __syncthreads();
        if (wid < 4) {
            const float lam = ((const float*)(ws + OFF_LAM))[layer];
            const float lam_init = layer == 0 ? 0.2f : 0.35550906759096926f;
            float ss = 0.f;
#pragma unroll
            for (int db = 0; db < 2; ++db)
#pragma unroll
                for (int i = 0; i < 16; ++i) { const float v = o[db][i] * inv - lam * xb[(wid * 32 + db * 16 + i) * 64 + lane]; o[db][i] = v; ss += v * v; }
            ss += __shfl_xor(ss, 32);
            const float rstd = rsqrtf(ss * (1.f / 64.f) + EPS) * (1.f - lam_init);
            const float* gs = p.sub_norm + layer * 64;
#pragma unroll
            for (int db = 0; db < 2; ++db)
#pragma unroll
                for (int i = 0; i < 16; ++i) o[db][i] *= gs[db * 32 + crow(i, h)];
            const int qi = qrow_blk + wid * 32 + l31;
            const size_t orow = ctxq ? (size_t)(NLAT + b * CTXL + (qi - SEQ)) : (size_t)(b * SEQ + qi);
            store_o(OCAT + orow * DM + 384 + head * 64, o, h, rstd);
        }
        __syncthreads(); }
    } else if (type == 2) { if (ATT_MASK & 4) {
        f32x16 o[2]; zero_o(o);
        float m = 0.f, l = 0.f;
        const bf16_t* Qg = (const bf16_t*)(ws + OFF_QC) + (size_t)(b * 6 + head) * SP * 96;
        const bf16_t* Kg = (const bf16_t*)(ws + OFF_KC) + (size_t)(b * 6 + head) * SP * 96;
        const bf16_t* Vg = (const bf16_t*)(ws + OFF_VTC) + (size_t)(b * 6 + head) * 64 * SP;
        attn_loop<96, 96>(Qg, Kg, Vg, qrow_blk + (tid >> 6) * 32, 0, ctxq ? SEQ : 0, ctxq ? 4 : SP / 64, 0, 0, false, 0, false, lds, o, m, l, tid);
        RELANE();
        const int qi = qrow_blk + wid * 32 + l31;
        const size_t orow = ctxq ? (size_t)(NLAT + b * CTXL + (qi - SEQ)) : (size_t)(b * SEQ + qi);
        const float lt = l + __shfl_xor(l, 32), inv = 1.f / lt;
        store_o(OCAT + orow * DM + 640 + head * 64, o, h, inv); }
    } else if (ATT_MASK & 1) {
        f32x16 o[2]; zero_o(o);
        const int kvh = head / 3;
        const bf16_t* Qg = (const bf16_t*)(ws + OFF_QA) + (size_t)(b * 6 + head) * SP * 64;
        const bf16_t* Kg = (const bf16_t*)(ws + OFF_KA) + (size_t)(b * 2 + kvh) * SP * 64;
        const bf16_t* Vg = (const bf16_t*)(ws + OFF_VTA) + (size_t)(b * 2 + kvh) * 64 * SP;
        float m = p.win_sink[layer * 6 + head] * LOG2E, l = (tid & 32) ? 0.f : 1.f;
        const int qb = qrow_blk >> 7, lo = (qb > 0 ? qb - 1 : 0) * 128, hi = (qb + 3 < 64 ? qb + 3 : 64) * 128;
        attn_loop<64, 64>(Qg, Kg, Vg, qrow_blk + (tid >> 6) * 32, 0, ctxq ? SEQ : lo, ctxq ? 4 : (hi - lo) >> 6, SEQ, ctxq ? 0 : 4, !ctxq, qrow_blk + (tid >> 6) * 32 + (tid & 31), true, lds, o, m, l, tid);
        RELANE();
        const int qi = qrow_blk + wid * 32 + l31;
        const size_t orow = ctxq ? (size_t)(NLAT + b * CTXL + (qi - SEQ)) : (size_t)(b * SEQ + qi);
        const float lt = l + __shfl_xor(l, 32), inv = 1.f / lt;
        store_o(OCAT + orow * DM + head * 64, o, h, inv);
    }
}

DI float wave_sum(float v) {
#pragma unroll
    for (int o = 32; o > 0; o >>= 1) v += __shfl_xor(v, o);
    return v;
}
typedef float f32x4n __attribute__((ext_vector_type(4)));
typedef unsigned u32x2n __attribute__((ext_vector_type(2)));
DI void load_row(const float* p, int lane, float4 (&v)[4]) {
#pragma unroll
    for (int j = 0; j < 4; ++j) { const f32x4n t = __builtin_nontemporal_load((const f32x4n*)(p + j * 256 + lane * 4)); v[j] = make_float4(t[0], t[1], t[2], t[3]); }
}
DI void load_row_bf(const bf16_t* p, int lane, float4 (&v)[4]) {
#pragma unroll
    for (int j = 0; j < 4; ++j) { const u32x2n wq = __builtin_nontemporal_load((const u32x2n*)(p + j * 256 + lane * 4)); const uint2 w = make_uint2(wq[0], wq[1]);
        v[j] = make_float4(__uint_as_float(w.x << 16), __uint_as_float(w.x & 0xffff0000u), __uint_as_float(w.y << 16), __uint_as_float(w.y & 0xffff0000u)); }
}
DI void load_row_part(const bf16_t* p, int lane, float4 (&v)[4]) {
    load_row_bf(p, lane, v);
#pragma unroll
    for (int q = 1; q < 4; ++q) { float4 t[4]; load_row_bf(p + (size_t)q * 512 * DM, lane, t);
#pragma unroll
        for (int j = 0; j < 4; ++j) { v[j].x += t[j].x; v[j].y += t[j].y; v[j].z += t[j].z; v[j].w += t[j].w; } }
}
DI float ssq_row(const float4 (&v)[4]) {
    float s = 0.f;
#pragma unroll
    for (int j = 0; j < 4; ++j) s += v[j].x * v[j].x + v[j].y * v[j].y + v[j].z * v[j].z + v[j].w * v[j].w;
    return wave_sum(s);
}
DI void norm_mod_store(const float4 (&x)[4], const float* g, const float* sh, const float* sc, bf16_t* dst, int lane) {
    const float rstd = rsqrtf(ssq_row(x) * (1.f / DM) + EPS);
#pragma unroll
    for (int j = 0; j < 4; ++j) {
        const int c = j * 256 + lane * 4;
        const float4 gg = *(const float4*)(g + c), s1 = *(const float4*)(sc + c), s0 = *(const float4*)(sh + c);
        st4(dst + c, x[j].x * rstd * gg.x * (1.f + s1.x) + s0.x, x[j].y * rstd * gg.y * (1.f + s1.y) + s0.y,
            x[j].z * rstd * gg.z * (1.f + s1.z) + s0.z, x[j].w * rstd * gg.w * (1.f + s1.w) + s0.w);
    }
}
DI void resid_add(float4 (&x)[4], const float4 (&y)[4], const float* g, const float* gt, int lane) {
    const float rstd = rsqrtf(ssq_row(y) * (1.f / DM) + EPS);
#pragma unroll
    for (int j = 0; j < 4; ++j) {
        const int c = j * 256 + lane * 4;
        const float4 gg = *(const float4*)(g + c), t = *(const float4*)(gt + c);
        x[j].x += t.x * (y[j].x * rstd * gg.x); x[j].y += t.y * (y[j].y * rstd * gg.y);
        x[j].z += t.z * (y[j].z * rstd * gg.z); x[j].w += t.w * (y[j].w * rstd * gg.w);
    }
}
DI void store_row(float* p, int lane, const float4 (&v)[4]) {
#pragma unroll
    for (int j = 0; j < 4; ++j) *(float4*)(p + j * 256 + lane * 4) = v[j];
}
DI const float* modp(const Params& p, int layer, int r) { const int v = r < NLAT ? (r >> 13) : 2; return (const float*)(p.ws + OFF_MOD) + (size_t)(layer * 3 + v) * 6144; }
DI float* xrow(const Params& p, int r) { return r < NLAT ? p.out + (size_t)r * DM : (float*)(p.ws + OFF_XCTX) + (size_t)(r - NLAT) * DM; }
DI const float* xin_row(const Params& p, int r) { return r < NLAT ? p.x + (size_t)r * DM : p.ctx + (size_t)(r - NLAT) * DM; }

DI void convT_task(const float* __restrict__ W0, const float* __restrict__ W1, int Nsrc, int K, int mid, const float* kscale, bf16_t* Bt, int tn, int tk, char* lds, const int tid) {
    float* tile = (float*)lds;
    const int tx = tid & 63, ty = tid >> 6;
    const int n = tn * 64 + tx;
    int src; const float* W = W0;
    switch (mid) {
        case 0: src = n < 640 ? n : (n < 1152 ? (n & ~31) + perm32(n & 31) : (n < 1792 ? n : (n < 1824 ? 1792 + perm32(n - 1792) : -1))); break;
        case 2: { const int q = n >> 6, t = (n >> 5) & 1, j = n & 31; src = q * 32 + j; W = t ? W1 : W0; } break;
        case 4: { if (n < 576) { const int hd = n / 96, w = n - hd * 96; src = hd * 96 + (w < 64 ? w : 64 + perm32(w - 64)); } else src = -1; } break;
        case 5: { if (n < 384) src = (n >> 6) * 128 + (n & 63); else { const int v = n - 384; src = (v >> 6) * 128 + 64 + (v & 63); } } break;
        default: src = n; break;
    }
    const int k0 = tk * 64;
    float vv[16];
#pragma unroll
    for (int i = 0; i < 16; ++i) { const int kk = ty + 4 * i; vv[i] = src >= 0 ? __builtin_nontemporal_load(&W[(size_t)(k0 + kk) * Nsrc + src]) : 0.f; }
#pragma unroll
    for (int i = 0; i < 16; ++i) { const int kk = ty + 4 * i; float v = vv[i]; if (kscale) v *= kscale[k0 + kk]; tile[kk * 65 + tx] = v; }
    __syncthreads();
    const int kp = tid & 31, nn0 = tid >> 5;
#pragma unroll
    for (int it = 0; it < 8; ++it) {
        const int nn = nn0 + 8 * it;
        *(unsigned*)(Bt + (size_t)(tn * 64 + nn) * K + k0 + 2 * kp) = pk2(tile[(2 * kp) * 65 + nn], tile[(2 * kp + 1) * 65 + nn]);
    }
    __syncthreads();
}
DI void ada_task(const Params& p, int layer, int jb, char* lds, const int tid) {
    float* sv = (float*)lds;
    float* red = sv + 3 * 1024;
    for (int i = tid; i < 3 * 1024; i += 256) { const int v = i >> 10, k = i & 1023; const float c = v < 2 ? p.c[v * 1024 + k] : p.c_ctx[k]; sv[i] = c / (1.f + __expf(-c)); }
    __syncthreads();
    const int kq = tid >> 3, c4 = (tid & 7) * 4;
    const float* W = p.w_ada + (size_t)layer * 1024 * 6144 + jb * 32 + c4;
    float acc[3][4];
#pragma unroll
    for (int v = 0; v < 3; ++v)
#pragma unroll
        for (int c = 0; c < 4; ++c) acc[v][c] = 0.f;
#pragma unroll
    for (int hb = 0; hb < 2; ++hb) {
        f32x4n wv[16];
#pragma unroll
        for (int i = 0; i < 16; ++i) wv[i] = __builtin_nontemporal_load((const f32x4n*)(W + (size_t)(kq + 32 * (hb * 16 + i)) * 6144));
#pragma unroll
        for (int i = 0; i < 16; ++i) { const int k = kq + 32 * (hb * 16 + i);
#pragma unroll
            for (int v = 0; v < 3; ++v) { const float sk = sv[v * 1024 + k];
#pragma unroll
                for (int c = 0; c < 4; ++c) acc[v][c] += sk * wv[i][c]; } }
    }
#pragma unroll
    for (int v = 0; v < 3; ++v)
#pragma unroll
        for (int c = 0; c < 4; ++c) red[(kq * 3 + v) * 32 + c4 + c] = acc[v][c];
    __syncthreads();
    if (tid < 96) {
        const int v = tid >> 5, jj = tid & 31, j = jb * 32 + jj;
        float sacc = 0.f;
#pragma unroll
        for (int q = 0; q < 32; ++q) sacc += red[(q * 3 + v) * 32 + jj];
        ((float*)(p.ws + OFF_MOD))[(size_t)(layer * 3 + v) * 6144 + j] = sacc + p.b_ada[layer * 6144 + j];
    }
    __syncthreads();
}

constexpr int T_ADA = 384;
constexpr int T_IN = 32 * 16, T_OUT = 16 * 16, T_GU = 88 * 16, T_DN = 16 * 44, T_QUP = 12 * 4, T_KVUP = 12 * 2;
constexpr int T_CONV_L = T_IN + T_OUT + T_GU + T_DN + T_QUP + T_KVUP;
constexpr int T_PREP = T_ADA + 2 * T_CONV_L;

DI void phase_prep(const Params& p, char* ws, char* lds, const int tid, const int VB, const int VG) {
    {
        float* ssq = (float*)(ws + OFF_SSQ);
        for (size_t i = (size_t)VB * 256 + tid; i < (size_t)2 * NROW * 2; i += (size_t)VG * 256) ssq[i] = 0.f;
        if (VB == 0 && tid < 64) ((unsigned*)(ws + OFF_CTR))[tid] = 0u;
        if (VB == VG - 1) {
            float2* T = (float2*)(ws + OFF_ROPE);
            for (int i = tid; i < 128 * 16; i += 256) { const int pos = i >> 4, f = i & 15; const float fr = powf(10000.f, -(float)f / 16.f); float sn, cs; sincosf((float)pos * fr, &sn, &cs); T[i] = make_float2(cs, sn); }
            if (tid < 2) {
                float d1 = 0.f, d2 = 0.f;
                for (int k = 0; k < 32; ++k) { d1 += p.lq1[tid * 32 + k] * p.lk1[tid * 32 + k]; d2 += p.lq2[tid * 32 + k] * p.lk2[tid * 32 + k]; }
                const float lam_init = tid == 0 ? 0.2f : 0.35550906759096926f;
                ((float*)(ws + OFF_LAM))[tid] = expf(d1) - expf(d2) + lam_init;
            }
        }
    }
    for (int t = VB; t < T_PREP; t += VG) {
        if (t < T_ADA) { ada_task(p, t / 192, t % 192, lds, tid); continue; }
        int u = t - T_ADA;
        const int layer = u / T_CONV_L; u -= layer * T_CONV_L;
        if (u < T_IN) { convT_task(p.w_in + (size_t)layer * DM * 1824, nullptr, 1824, DM, 0, nullptr, (bf16_t*)(ws + OFF_BT_IN + layer * SZ_BT_IN), u >> 4, u & 15, lds, tid); continue; }
        u -= T_IN;
        if (u < T_OUT) { convT_task(p.w_out + (size_t)layer * DM * DM, nullptr, DM, DM, 1, nullptr, (bf16_t*)(ws + OFF_BT_OUT + layer * SZ_BT_OUT), u >> 4, u & 15, lds, tid); continue; }
        u -= T_OUT;
        if (u < T_GU) { convT_task(p.w_gate + (size_t)layer * DM * DFF, p.w_up + (size_t)layer * DM * DFF, DFF, DM, 2, nullptr, (bf16_t*)(ws + OFF_BT_GU + layer * SZ_BT_GU), u >> 4, u & 15, lds, tid); continue; }
        u -= T_GU;
        if (u < T_DN) { convT_task(p.w_down + (size_t)layer * DFF * DM, nullptr, DM, DFF, 3, nullptr, (bf16_t*)(ws + OFF_BT_DN + layer * SZ_BT_DN), u / 44, u % 44, lds, tid); continue; }
        u -= T_DN;
        if (u < T_QUP) { convT_task(p.w_q_up + (size_t)layer * 256 * 576, nullptr, 576, 256, 4, p.q_norm + layer * 256, (bf16_t*)(ws + OFF_BT_QUP + layer * SZ_BT_QUP), u >> 2, u & 3, lds, tid); continue; }
        u -= T_QUP;
        convT_task(p.w_kv_up + (size_t)layer * 128 * 768, nullptr, 768, 128, 5, p.kv_norm + layer * 128, (bf16_t*)(ws + OFF_BT_KVUP + layer * SZ_BT_KVUP), u >> 1, u & 1, lds, tid);
    }
}

DI int attn_nt(int u) {
    if (u < U_C + U_B) return SP / 64;
    if (u < U_LAT) { const int qb = (u - U_C - U_B) & 63; return (qb == 0 || qb == 63) ? 8 : 10; }
    return 4;
}
__global__ void __launch_bounds__(512) fwd_mega(Params p) {
    __shared__ __attribute__((aligned(16))) char lds[LDS_BYTES];
    __shared__ int s_unit;
    __shared__ uint4 xb_words;
    cg::grid_group grid = cg::this_grid();
    if (threadIdx.x == 0) xb_words = make_uint4(0u, 0u, 0u, 0u);
    __syncthreads();
    const XcdBarrier xb = xcd_barrier_post((unsigned*)(p.ws + OFF_BAR), (volatile LAS unsigned*)&xb_words);
    for (int ph = p.ph_lo; ph < p.ph_hi; ++ph) {
        int tid5 = threadIdx.x; asm volatile("" : "+v"(tid5));
        size_t zoff = 0; asm volatile("" : "+s"(zoff));
        char* ws = p.ws + zoff;
        const int half = tid5 >> 8, tid = tid5 & 255, VB = blockIdx.x * 2 + half, VG = gridDim.x * 2;
        char* vlds = lds + half * HALF_LDS;
        const int lane = tid & 63, wid = tid >> 6;
        if (ph == 0) { if (PHON(0)) phase_prep(p, ws, vlds, tid, VB, VG); }
        else if (ph == 1 && PHON(1)) {
            bf16_t* H = (bf16_t*)(ws + OFF_H);
            for (int r = VB * 4 + wid; r < NROW; r += VG * 4) {
                float4 x[4]; load_row(xin_row(p, r), lane, x);
                const float* md = modp(p, 0, r);
                norm_mod_store(x, p.g_pre_mix, md, md + 1024, H + (size_t)r * DM, lane);
            }
        } else if (ph >= 2) {
            const int layer = (ph - 2) >> 3, sub = (ph - 2) & 7;
            const int MR = layer == 0 ? NROW : NLAT;
            if (sub == 0 && PHON(2)) {
                EpiIn epi{ws, (float*)(ws + OFF_SSQ) + (size_t)layer * NROW * 2, (const float2*)(ws + OFF_ROPE), true};
                const bf16_t* A = (const bf16_t*)(ws + OFF_H); const bf16_t* Bt = (const bf16_t*)(ws + OFF_BT_IN + layer * SZ_BT_IN);
                for (int t = blockIdx.x; t < (NROW / 256) * 7; t += gridDim.x) { int mt, nt; tile_mn(t, NROW / 256, 7, mt, nt); gemm256(A, DM, Bt, DM, DM, mt * 256, nt * 256, lds, epi, tid5); }
                for (int t = VG - 1 - VB; t < NROW / 128; t += VG) { int tt = threadIdx.x & 255; asm volatile("" : "+v"(tt)); gemm_tile(A, DM, Bt, DM, DM, t * 128, 1792, vlds, epi, tt); }
            } else if (sub == 1 && PHON(3)) {
                const float* ssq = (const float*)(ws + OFF_SSQ) + (size_t)layer * NROW * 2;
                EpiQup eq{ws, ssq, (const float2*)(ws + OFF_ROPE)}; EpiKvup ek{ws, ssq};
                const int nQ = (NROW / 256) * 3;
                for (int t = blockIdx.x; t < 2 * nQ; t += gridDim.x) {
                    if (t < nQ) { const int nt = t / (NROW / 256), mt = t - nt * (NROW / 256); gemm256((const bf16_t*)(ws + OFF_CQ), 256, (const bf16_t*)(ws + OFF_BT_QUP + layer * SZ_BT_QUP), 256, 256, mt * 256, nt * 256, lds, eq, tid5); }
                    else { const int v = t - nQ, nt = v / (NROW / 256), mt = v - nt * (NROW / 256); gemm256((const bf16_t*)(ws + OFF_CKV), 128, (const bf16_t*)(ws + OFF_BT_KVUP + layer * SZ_BT_KVUP), 128, 128, mt * 256, nt * 256, lds, ek, tid5); }
                }
            } else if (sub == 2 && PHON(4)) {
                unsigned* ctr = (unsigned*)(ws + OFF_CTR) + (layer * 2) * 8;
                const int qcount = layer == 0 ? 165 : 160;
                const int home = (int)(xb.x & 7u);
                for (int qq = 0; qq < 8; ++qq) {
                    const int q = (home + qq) & 7;
                    for (;;) {
                        if (threadIdx.x == 0) s_unit = (int)atomicAdd(ctr + q, 1u);
                        __syncthreads();
                        const int j = s_unit;
                        __syncthreads();
                        if (j >= qcount) break;
                        int u;
                        if (j < 16) u = (8 + (q >> 1)) * 32 + (q & 1) * 16 + j;
                        else if (j < 80) u = U_C + q * 64 + (j - 16);
                        else if (j < 112) u = q * 32 + (j - 80);
                        else if (j < 160) u = U_C + U_B + q * 48 + (j - 112);
                        else u = U_LAT + q * 5 + (j - 160);
                        int tid_u = threadIdx.x; asm volatile("" : "+v"(tid_u));
                        attn_unit(p, ws, layer, u, lds, tid_u);
                    }
                }
            } else if (sub == 3 && PHON(5)) {
                EpiF32 epi{(bf16_t*)(ws + OFF_MIX)};
                const bf16_t* A = (const bf16_t*)(ws + OFF_H); const bf16_t* Bt = (const bf16_t*)(ws + OFF_BT_OUT + layer * SZ_BT_OUT);
                for (int t = blockIdx.x; t < (NLAT / 256) * 4; t += gridDim.x) { int mt, nt; tile_mn(t, NLAT / 256, 4, mt, nt); gemm256(A, DM, Bt, DM, DM, mt * 256, nt * 256, lds, epi, tid5); }
                if (layer == 0)
                    for (int e = blockIdx.x; e < 32; e += gridDim.x) {
                        const int tl = e >> 2, q = e & 3;
                        EpiF32 ep{(bf16_t*)(ws + OFF_PART) + (size_t)q * 512 * DM - (size_t)NLAT * DM};
                        gemm256(A + q * (DM / 4), DM, Bt + q * (DM / 4), DM, DM / 4, (NLAT / 256 + (tl >> 2)) * 256, (tl & 3) * 256, lds, ep, tid5);
                    }
            } else if (sub == 4 && PHON(6)) {
                bf16_t* H = (bf16_t*)(ws + OFF_H); const bf16_t* MIX = (const bf16_t*)(ws + OFF_MIX);
                for (int r = VB * 4 + wid; r < MR; r += VG * 4) {
                    float4 x[4], y[4];
                    load_row(layer == 0 ? xin_row(p, r) : xrow(p, r), lane, x);
                    if (r >= NLAT) load_row_part((const bf16_t*)(ws + OFF_PART) + (size_t)(r - NLAT) * DM, lane, y); else load_row_bf(MIX + (size_t)r * DM, lane, y);
                    const float* md = modp(p, layer, r);
                    resid_add(x, y, p.g_post_mix + layer * DM, md + 2048, lane);
                    store_row(xrow(p, r), lane, x);
                    norm_mod_store(x, p.g_pre_ffn + layer * DM, md + 3072, md + 4096, H + (size_t)r * DM, lane);
                }
            } else if (sub == 5 && PHON(7)) {
                EpiGU epi{(bf16_t*)(ws + OFF_G)};
                const bf16_t* A = (const bf16_t*)(ws + OFF_H); const bf16_t* Bt = (const bf16_t*)(ws + OFF_BT_GU + layer * SZ_BT_GU);
                for (int t = blockIdx.x; t < (MR / 256) * 22; t += gridDim.x) { int mt, nt; tile_mn(t, MR / 256, 22, mt, nt); gemm256(A, DM, Bt, DM, DM, mt * 256, nt * 256, lds, epi, tid5); }
            } else if (sub == 6 && PHON(8)) {
                EpiF32 epi{(bf16_t*)(ws + OFF_MIX)};
                const bf16_t* A = (const bf16_t*)(ws + OFF_G); const bf16_t* Bt = (const bf16_t*)(ws + OFF_BT_DN + layer * SZ_BT_DN);
                for (int t = blockIdx.x; t < (NLAT / 256) * 4; t += gridDim.x) { int mt, nt; tile_mn(t, NLAT / 256, 4, mt, nt); gemm256(A, DFF, Bt, DFF, DFF, mt * 256, nt * 256, lds, epi, tid5); }
                if (layer == 0)
                    for (int e = blockIdx.x; e < 32; e += gridDim.x) {
                        const int tl = e >> 2, q = e & 3;
                        EpiF32 ep{(bf16_t*)(ws + OFF_PART) + (size_t)q * 512 * DM - (size_t)NLAT * DM};
                        gemm256(A + q * (DFF / 4), DFF, Bt + q * (DFF / 4), DFF, DFF / 4, (NLAT / 256 + (tl >> 2)) * 256, (tl & 3) * 256, lds, ep, tid5);
                    }
            } else if (sub == 7 && PHON(9)) {
                bf16_t* H = (bf16_t*)(ws + OFF_H); const bf16_t* F = (const bf16_t*)(ws + OFF_MIX);
                for (int r = VB * 4 + wid; r < MR; r += VG * 4) {
                    float4 x[4], y[4];
                    load_row(xrow(p, r), lane, x);
                    if (r >= NLAT) load_row_part((const bf16_t*)(ws + OFF_PART) + (size_t)(r - NLAT) * DM, lane, y); else load_row_bf(F + (size_t)r * DM, lane, y);
                    const float* md = modp(p, layer, r);
                    resid_add(x, y, p.g_post_ffn + layer * DM, md + 5120, lane);
                    store_row(xrow(p, r), lane, x);
                    if (layer == 0) { const float* md1 = modp(p, 1, r); norm_mod_store(x, p.g_pre_mix + DM, md1, md1 + 1024, H + (size_t)r * DM, lane); }
                }
            }
        }
        if (ph + 1 < p.ph_hi) { if (ph < 0) grid.sync(); else xcd_barrier(xb); }
    }
}

extern "C" void kernel_launch(void* const* d_in, const int* in_sizes, int n_in, void* d_out, int out_size, void* d_ws, size_t ws_size, hipStream_t stream) {
    static int grid_blocks = 0;
    if (!grid_blocks) {
        int dev = 0, cus = 0, per_cu = 0;
        hipGetDevice(&dev);
        hipDeviceGetAttribute(&cus, hipDeviceAttributeMultiprocessorCount, dev);
        hipOccupancyMaxActiveBlocksPerMultiprocessor(&per_cu, fwd_mega, 512, 0);
        if (per_cu > 1) per_cu = 1;
        grid_blocks = cus * per_cu;
        if (ws_size < WS_NEED) fprintf(stderr, "kernel_launch: ws too small: %zu < %zu\n", ws_size, (size_t)WS_NEED);
    }
    Params p;
    memset(&p, 0, sizeof(p));
    const float* const* in = (const float* const*)d_in;
    p.x = in[0]; p.c = in[1]; p.ctx = in[2]; p.c_ctx = in[3]; p.w_ada = in[4]; p.b_ada = in[5]; p.g_pre_mix = in[6]; p.g_post_mix = in[7];
    p.w_in = in[8]; p.win_sink = in[9]; p.lq1 = in[10]; p.lk1 = in[11]; p.lq2 = in[12]; p.lk2 = in[13]; p.sub_norm = in[14];
    p.q_norm = in[15]; p.w_q_up = in[16]; p.kv_norm = in[17]; p.w_kv_up = in[18]; p.w_out = in[19]; p.g_pre_ffn = in[20]; p.g_post_ffn = in[21];
    p.w_gate = in[22]; p.w_up = in[23]; p.w_down = in[24];
    p.out = (float*)d_out; p.ws = (char*)d_ws; p.ph_lo = 0; p.ph_hi = NPHASE;
    (void)hipMemsetAsync((char*)d_ws + OFF_BAR, 0, XCD_BAR_WORDS * 4, stream);
    void* args[] = {&p};
    hipError_t e = hipLaunchCooperativeKernel((void*)fwd_mega, dim3(grid_blocks), dim3(512), args, 0, stream);
    if (e != hipSuccess) fprintf(stderr, "cooperative launch failed: %s (grid %d)\n", hipGetErrorString(e), grid_blocks);
}
```

```cpp
#include <hip/hip_runtime.h>
#include <hip/hip_cooperative_groups.h>
#include <cstdio>
#include <cstdint>
#include <cstring>
namespace cg = cooperative_groups;

#define DI __device__ __forceinline__
typedef unsigned short bf16_t;
typedef short bf16x8 __attribute__((ext_vector_type(8)));
typedef float f32x16 __attribute__((ext_vector_type(16)));
typedef __bf16 bf16x2_t __attribute__((ext_vector_type(2)));
typedef float f32x2_t __attribute__((ext_vector_type(2)));
typedef unsigned u32x4 __attribute__((ext_vector_type(4)));

constexpr int SEQ = 8192, CTXL = 256, SP = SEQ + CTXL, NLAT = 2 * SEQ, NROW = NLAT + 2 * CTXL, DM = 1024, DFF = 2816;
constexpr int N_IN = 2048, N_GU = 2 * DFF, N_QUP = 768, N_KVUP = 768;
constexpr float LOG2E = 1.4426950408889634f;
constexpr float EPS = 1e-6f;
constexpr int NPHASE = 18;
constexpr int LDS_BYTES = 147456;
constexpr int HALF_LDS = 73728;
#ifndef PH_MASK
#define PH_MASK 0x3ff
#endif
#define PHON(k) ((PH_MASK >> (k)) & 1)
#ifndef REP_IN
#define REP_IN 1
#endif
#ifndef REP_UP
#define REP_UP 1
#endif
#ifndef REP_ATTN
#define REP_ATTN 1
#endif
#ifndef REP_OUT
#define REP_OUT 1
#endif
#ifndef REP_GU
#define REP_GU 1
#endif
#ifndef REP_DN
#define REP_DN 1
#endif

constexpr size_t al256(size_t x) { return (x + 255) / 256 * 256; }
constexpr size_t SZ_BT_IN = (size_t)N_IN * DM * 2, SZ_BT_OUT = (size_t)DM * DM * 2, SZ_BT_GU = (size_t)N_GU * DM * 2, SZ_BT_DN = (size_t)DM * DFF * 2;
constexpr size_t SZ_BT_QUP = (size_t)N_QUP * 256 * 2, SZ_BT_KVUP = (size_t)N_KVUP * 128 * 2;
constexpr size_t OFF_CTR = 0;
constexpr size_t OFF_LAM = 256;
constexpr size_t OFF_BAR = 512;
constexpr size_t OFF_ROPE = 512 + 3456 * 4;
constexpr size_t OFF_MOD = OFF_ROPE + 128 * 16 * 8;
constexpr size_t OFF_SSQ = al256(OFF_MOD + 2 * 3 * 6144 * 4);
constexpr size_t OFF_BT_IN = al256(OFF_SSQ + (size_t)2 * NROW * 2 * 4);
constexpr size_t OFF_BT_OUT = OFF_BT_IN + 2 * SZ_BT_IN;
constexpr size_t OFF_BT_GU = OFF_BT_OUT + 2 * SZ_BT_OUT;
constexpr size_t OFF_BT_DN = OFF_BT_GU + 2 * SZ_BT_GU;
constexpr size_t OFF_BT_QUP = OFF_BT_DN + 2 * SZ_BT_DN;
constexpr size_t OFF_BT_KVUP = OFF_BT_QUP + 2 * SZ_BT_QUP;
constexpr size_t OFF_XCTX = OFF_BT_KVUP + 2 * SZ_BT_KVUP;
constexpr size_t OFF_H = OFF_XCTX + (size_t)512 * DM * 4;
constexpr size_t OFF_BR = OFF_H + (size_t)NROW * DM * 2;
constexpr size_t SZ_Q64 = (size_t)SP * 64 * 2, SZ_Q96 = (size_t)SP * 96 * 2;
constexpr size_t OFF_QA = OFF_BR, OFF_KA = OFF_QA + 12 * SZ_Q64, OFF_VTA = OFF_KA + 4 * SZ_Q64, OFF_QB = OFF_VTA + 4 * SZ_Q64,
                 OFF_KB = OFF_QB + 8 * SZ_Q64, OFF_VTB = OFF_KB + 8 * SZ_Q64, OFF_QC = OFF_VTB + 8 * SZ_Q64, OFF_KC = OFF_QC + 12 * SZ_Q96,
                 OFF_VTC = OFF_KC + 12 * SZ_Q96, OFF_CQ = OFF_VTC + 12 * SZ_Q64, OFF_CKV = OFF_CQ + (size_t)NROW * 256 * 2,
                 OFF_ATT_END = OFF_CKV + (size_t)NROW * 128 * 2;
constexpr size_t OFF_G = OFF_BR;
constexpr size_t OFF_G_END = OFF_G + (size_t)NROW * DFF * 2;
constexpr size_t OFF_MIX = al256(OFF_G_END > OFF_ATT_END ? OFF_G_END : OFF_ATT_END);
constexpr size_t OFF_PART = OFF_MIX + (size_t)NROW * DM * 2;
constexpr size_t WS_NEED = OFF_MIX + (size_t)NROW * DM * 4;

struct Params {
    const float *x, *c, *ctx, *c_ctx, *w_ada, *b_ada, *g_pre_mix, *g_post_mix, *w_in, *win_sink, *lq1, *lk1, *lq2, *lk2, *sub_norm,
        *q_norm, *w_q_up, *kv_norm, *w_kv_up, *w_out, *g_pre_ffn, *g_post_ffn, *w_gate, *w_up, *w_down;
    float* out;
    char* ws;
    int ph_lo, ph_hi;
};

DI unsigned pk2(float a, float b) { f32x2_t v = {a, b}; bf16x2_t r = __builtin_convertvector(v, bf16x2_t); return __builtin_bit_cast(unsigned, r); }
DI bf16_t tobf(float a) { return (bf16_t)(pk2(a, 0.f) & 0xffffu); }
DI void st4(bf16_t* p, float a, float b, float c, float d) { *(uint2*)p = make_uint2(pk2(a, b), pk2(c, d)); }
DI int crow(int i, int h) { return (i & 3) + 8 * (i >> 2) + 4 * h; }
DI int perm16(int s) { return (s & ~12) | ((s & 4) << 1) | ((s & 8) >> 1); }
DI int perm32(int p) { return p < 8 ? p : (p < 16 ? p + 8 : (p < 24 ? p - 8 : p)); }
DI f32x16 mfma(bf16x8 a, bf16x8 b, f32x16 c) { return __builtin_amdgcn_mfma_f32_32x32x16_bf16(a, b, c, 0, 0, 0); }
DI bf16x8 pack8(const f32x16& x, int s) {
    uint4 w = make_uint4(pk2(x[8 * s + 0], x[8 * s + 1]), pk2(x[8 * s + 2], x[8 * s + 3]), pk2(x[8 * s + 4], x[8 * s + 5]), pk2(x[8 * s + 6], x[8 * s + 7]));
    return __builtin_bit_cast(bf16x8, w);
}
DI float silu(float x) { return x * __builtin_amdgcn_rcpf(1.f + __expf(-x)); }

struct RowInfo { int b, sp, prow, pcol; bool lat; };
DI RowInfo rowinfo(int r) {
    RowInfo ri;
    if (r < NLAT) { ri.lat = true; ri.b = r >> 13; int s = r & (SEQ - 1); ri.sp = s; ri.prow = s >> 6; ri.pcol = s & 63; }
    else { int c = r - NLAT; ri.lat = false; ri.b = c >> 8; ri.sp = SEQ + (c & 255); ri.prow = 0; ri.pcol = 0; }
    return ri;
}
DI void rope_a(f32x16& v, const float2* T, int pos, int h) {
#pragma unroll
    for (int i = 0; i < 8; ++i) { const float2 cs = T[pos * 16 + crow(i, h)]; const float x1 = v[i], x2 = v[i + 8]; v[i] = x1 * cs.x - x2 * cs.y; v[i + 8] = x2 * cs.x + x1 * cs.y; }
}
DI void rope_b(f32x16& v, const float2* T, int prow, int pcol, int h) {
#pragma unroll
    for (int i = 0; i < 8; ++i) { const int pos = i < 4 ? prow : pcol; const float2 cs = T[pos * 16 + 2 * ((i & 3) + 4 * h)];
        const float x1 = v[i], x2 = v[i + 8]; v[i] = x1 * cs.x - x2 * cs.y; v[i + 8] = x2 * cs.x + x1 * cs.y; }
}
DI void store16_bf(bf16_t* dst, const f32x16& v, int h, float sc) {
#pragma unroll
    for (int i4 = 0; i4 < 4; ++i4) st4(dst + 8 * i4 + 4 * h, v[4 * i4] * sc, v[4 * i4 + 1] * sc, v[4 * i4 + 2] * sc, v[4 * i4 + 3] * sc);
}
DI void store16_vt(bf16_t* vt_d0, const f32x16& v, int h, float sc, int spp) {
#pragma unroll
    for (int i = 0; i < 16; ++i) vt_d0[(size_t)crow(i, h) * SP + spp] = tobf(v[i] * sc);
}


#define XB_TMO      128
#define XB_XCNT(j)  (256  + 64 * (j))
#define XB_XSUB(j)  (1280 + 64 * (j))
#define XB_XGEN(j)  (2304 + 64 * (j))
#define XB_TOP      3328
#define XB_TOPGEN   3392
#define XCD_BAR_WORDS 3456
#define XB_SPIN_CAP (1u << 20)
#define LAS __attribute__((address_space(3)))
DI unsigned xb_ld(unsigned* p)              { return __hip_atomic_load(p, __ATOMIC_RELAXED, __HIP_MEMORY_SCOPE_AGENT); }
DI unsigned xb_add(unsigned* p, unsigned v) { return __hip_atomic_fetch_add(p, v, __ATOMIC_RELAXED, __HIP_MEMORY_SCOPE_AGENT); }
DI unsigned xb_xcc_id() { return (unsigned)__builtin_amdgcn_s_getreg((3 << 11) | 20) & 0xFu; }
#define XB_SPIN(cond, bar) do { unsigned _sp = 0; while (cond) { __builtin_amdgcn_s_sleep(1); \
    if ((++_sp & 255u) == 0u) { if (xb_ld(&(bar)[XB_TMO])) break; if (_sp > XB_SPIN_CAP) { atomicAdd(&(bar)[XB_TMO], 1u); break; } } } } while (0)
struct XcdBarrier { unsigned* bar; unsigned x; volatile LAS unsigned* st; };
DI XcdBarrier xcd_barrier_post(unsigned* bar, volatile LAS unsigned* st) {
    XcdBarrier b; b.bar = bar; b.x = xb_xcc_id(); b.st = st;
    if (threadIdx.x == 0) (void)xb_add(&bar[XB_XCNT(b.x)], 1u);
    return b;
}
DI void xcd_barrier_complete(unsigned* bar, unsigned x, unsigned& nloc, unsigned& nx) {
    const unsigned G = gridDim.x * gridDim.y * gridDim.z;
    unsigned sum, cnt, mine, sp = 0u;
    for (;;) {
        sum = 0u; cnt = 0u; mine = 0u;
#pragma unroll
        for (unsigned j = 0; j < 16; ++j) { const unsigned c = xb_ld(&bar[XB_XCNT(j)]); sum += c; cnt += (c > 0u) ? 1u : 0u; mine = (j == x) ? c : mine; }
        if (sum == G) break;
        __builtin_amdgcn_s_sleep(1);
        if ((++sp & 255u) == 0u) { if (xb_ld(&bar[XB_TMO])) break; if (sp > XB_SPIN_CAP) { atomicAdd(&bar[XB_TMO], 1u); break; } }
    }
    nloc = mine > 0u ? mine : 1u; nx = cnt > 0u ? cnt : 1u;
}
DI void xcd_barrier(const XcdBarrier& b) {
    asm volatile("s_waitcnt vmcnt(0)" ::: "memory");
    __syncthreads();
    if (threadIdx.x == 0) {
        unsigned* bar = b.bar;
        __builtin_amdgcn_s_waitcnt(0);
        unsigned nloc = b.st[0], nx = b.st[1];
        if (nloc == 0u) { xcd_barrier_complete(bar, b.x, nloc, nx); b.st[0] = nloc; b.st[1] = nx; }
        const unsigned old = xb_add(&bar[XB_XSUB(b.x)], 1u);
        const unsigned gen = old / nloc;
        if (old + 1u == (gen + 1u) * nloc) {
            __builtin_amdgcn_fence(__ATOMIC_RELEASE, "agent");
            asm volatile("s_waitcnt vmcnt(0)" ::: "memory");
            const unsigned og = xb_add(&bar[XB_TOP], 1u);
            const unsigned tg = og / nx;
            if (og + 1u == (tg + 1u) * nx) xb_add(&bar[XB_TOPGEN], 1u);
            else XB_SPIN(xb_ld(&bar[XB_TOPGEN]) == tg, bar);
            __builtin_amdgcn_fence(__ATOMIC_ACQUIRE, "agent");
            xb_add(&bar[XB_XGEN(b.x)], 1u);
            asm volatile("s_waitcnt vmcnt(0)" ::: "memory");
        } else {
            XB_SPIN(xb_ld(&bar[XB_XGEN(b.x)]) == gen, bar);
            __builtin_amdgcn_fence(__ATOMIC_ACQUIRE, "agent");
            asm volatile("s_waitcnt vmcnt(0)" ::: "memory");
        }
    }
    __syncthreads();
}

constexpr int LROW = 144;
constexpr int G_STAGE = 2 * 128 * LROW;

template <class Epi>
DI void gemm_tile(const bf16_t* __restrict__ A, int lda, const bf16_t* __restrict__ Bt, int ldb, int K, int m0, int n0, char* lds, const Epi& epi, const int tid) {
    const int lane = tid & 63, wid = tid >> 6, wm = wid >> 1, wn = wid & 1, l31 = lane & 31, h = lane >> 5;
    const int lrow = tid >> 3, lkc = tid & 7;
    const bf16_t* Ag = A + (size_t)(m0 + lrow) * lda + lkc * 8;
    const bf16_t* Bg = Bt + (size_t)(n0 + lrow) * ldb + lkc * 8;
    const size_t a32 = (size_t)32 * lda, b32 = (size_t)32 * ldb;
    const int lw = lrow * LROW + lkc * 16;
    u32x4 S0a0, S0a1, S0a2, S0a3, S0b0, S0b1, S0b2, S0b3, S1a0, S1a1, S1a2, S1a3, S1b0, S1b1, S1b2, S1b3, S2a0, S2a1, S2a2, S2a3, S2b0, S2b1, S2b2, S2b3;
    f32x16 acc[2][2];
#pragma unroll
    for (int i = 0; i < 2; ++i)
#pragma unroll
        for (int j = 0; j < 2; ++j)
#pragma unroll
            for (int e = 0; e < 16; ++e) acc[i][j][e] = 0.f;
    const int KT = K >> 6;
#define GLOAD(S, kt_) do { const bf16_t* ap_ = Ag + ((kt_) << 6); const bf16_t* bp_ = Bg + ((kt_) << 6); \
        S##a0 = *(const u32x4*)(ap_); S##a1 = *(const u32x4*)(ap_ + a32); S##a2 = *(const u32x4*)(ap_ + 2 * a32); S##a3 = *(const u32x4*)(ap_ + 3 * a32); \
        S##b0 = *(const u32x4*)(bp_); S##b1 = *(const u32x4*)(bp_ + b32); S##b2 = *(const u32x4*)(bp_ + 2 * b32); S##b3 = *(const u32x4*)(bp_ + 3 * b32); } while (0)
#define GWRITE(S, buf_) do { char* wb_ = lds + (buf_) * G_STAGE + lw; \
        *(u32x4*)(wb_) = S##a0; *(u32x4*)(wb_ + 32 * LROW) = S##a1; *(u32x4*)(wb_ + 64 * LROW) = S##a2; *(u32x4*)(wb_ + 96 * LROW) = S##a3; \
        *(u32x4*)(wb_ + 128 * LROW) = S##b0; *(u32x4*)(wb_ + 160 * LROW) = S##b1; *(u32x4*)(wb_ + 192 * LROW) = S##b2; *(u32x4*)(wb_ + 224 * LROW) = S##b3; } while (0)
    const int aoff = (wm * 64 + l31) * LROW + h * 16;
    const int boff = 128 * LROW + (wn * 64 + l31) * LROW + h * 16;
#define GCOMP(kt_) do { const char* base_ = lds + ((kt_) & 1) * G_STAGE; \
        _Pragma("unroll") for (int ks = 0; ks < 4; ++ks) { \
            const bf16x8 a0 = *(const bf16x8*)(base_ + aoff + ks * 32), a1 = *(const bf16x8*)(base_ + aoff + 32 * LROW + ks * 32); \
            const bf16x8 b0 = *(const bf16x8*)(base_ + boff + ks * 32), b1 = *(const bf16x8*)(base_ + boff + 32 * LROW + ks * 32); \
            acc[0][0] = mfma(b0, a0, acc[0][0]); acc[0][1] = mfma(b0, a1, acc[0][1]); \
            acc[1][0] = mfma(b1, a0, acc[1][0]); acc[1][1] = mfma(b1, a1, acc[1][1]); } } while (0)
#define GITER(kt_, SL, SW) do { if ((kt_) + 3 < KT) GLOAD(SL, (kt_) + 3); GCOMP(kt_); if ((kt_) + 1 < KT) GWRITE(SW, ((kt_) + 1) & 1); __syncthreads(); } while (0)
    GLOAD(S0, 0);
    if (KT > 1) GLOAD(S1, 1);
    if (KT > 2) GLOAD(S2, 2);
    GWRITE(S0, 0);
    __syncthreads();
    int kt = 0;
    for (; kt + 3 <= KT; kt += 3) { GITER(kt, S0, S1); GITER(kt + 1, S1, S2); GITER(kt + 2, S2, S0); }
    if (kt < KT) { GITER(kt, S0, S1); if (kt + 1 < KT) GITER(kt + 1, S1, S2); }
#undef GLOAD
#undef GWRITE
#undef GCOMP
#undef GITER
    epi(acc, m0 + wm * 64, n0 + wn * 64, lane);
}

DI bool tile_xcd(int i, int MT, int NT, int& mt, int& nt) {
    const int x = blockIdx.x & 7, slot = blockIdx.x >> 3, nslot = (gridDim.x + 7 - x) >> 3;
    const int cnt = (MT - x + 7) >> 3;
    const int j = slot + i * nslot;
    if (j >= cnt * NT) return false;
    const int per = 4 * NT, g = j / per, r = j - g * per, gm = (cnt - g * 4) < 4 ? (cnt - g * 4) : 4;
    nt = r / gm; mt = x + 8 * (g * 4 + (r - nt * gm));
    return true;
}

constexpr int G2_STAGE = 512 * LROW;
template <class Epi>
DI void gemm256(const bf16_t* __restrict__ A, int lda, const bf16_t* __restrict__ Bt, int ldb, int K, int m0, int n0, char* lds, const Epi& epi, const int tid) {
    const int lane = tid & 63, wid = tid >> 6, wm = wid >> 2, wn = wid & 3, l31 = lane & 31, h = lane >> 5;
    const int lrow = tid >> 3, lkc = tid & 7;
    const bf16_t* Ag = A + (size_t)(m0 + lrow) * lda + lkc * 8;
    const bf16_t* Bg = Bt + (size_t)(n0 + lrow) * ldb + lkc * 8;
    const size_t a64 = (size_t)64 * lda, b64 = (size_t)64 * ldb;
    const int lw = lrow * LROW + lkc * 16;
    u32x4 S0a0, S0a1, S0a2, S0a3, S0b0, S0b1, S0b2, S0b3;
    f32x16 acc[2][2][2];
#pragma unroll
    for (int a = 0; a < 2; ++a)
#pragma unroll
        for (int i = 0; i < 2; ++i)
#pragma unroll
            for (int j = 0; j < 2; ++j)
#pragma unroll
                for (int e = 0; e < 16; ++e) acc[a][i][j][e] = 0.f;
    const int KT = K >> 6;
#define GLOAD(S, kt_) do { const bf16_t* ap_ = Ag + ((kt_) << 6); const bf16_t* bp_ = Bg + ((kt_) << 6); \
        S##a0 = *(const u32x4*)(ap_); S##a1 = *(const u32x4*)(ap_ + a64); S##a2 = *(const u32x4*)(ap_ + 2 * a64); S##a3 = *(const u32x4*)(ap_ + 3 * a64); \
        S##b0 = *(const u32x4*)(bp_); S##b1 = *(const u32x4*)(bp_ + b64); S##b2 = *(const u32x4*)(bp_ + 2 * b64); S##b3 = *(const u32x4*)(bp_ + 3 * b64); } while (0)
#define GWRITE(S, buf_) do { char* wb_ = lds + (buf_) * G2_STAGE + lw; \
        *(u32x4*)(wb_) = S##a0; *(u32x4*)(wb_ + 64 * LROW) = S##a1; *(u32x4*)(wb_ + 128 * LROW) = S##a2; *(u32x4*)(wb_ + 192 * LROW) = S##a3; \
        *(u32x4*)(wb_ + 256 * LROW) = S##b0; *(u32x4*)(wb_ + 320 * LROW) = S##b1; *(u32x4*)(wb_ + 384 * LROW) = S##b2; *(u32x4*)(wb_ + 448 * LROW) = S##b3; } while (0)
    const int aoff = (wm * 128 + l31) * LROW + h * 16;
    const int boff = 256 * LROW + (wn * 64 + l31) * LROW + h * 16;
#define GCOMP1(kt_, ks0_) do { const char* base_ = lds + ((kt_) & 1) * G2_STAGE; \
        _Pragma("unroll") for (int ks = (ks0_); ks < (ks0_) + 1; ++ks) { \
            const bf16x8 a0 = *(const bf16x8*)(base_ + aoff + ks * 32), a1 = *(const bf16x8*)(base_ + aoff + 32 * LROW + ks * 32); \
            const bf16x8 a2 = *(const bf16x8*)(base_ + aoff + 64 * LROW + ks * 32), a3 = *(const bf16x8*)(base_ + aoff + 96 * LROW + ks * 32); \
            const bf16x8 b0 = *(const bf16x8*)(base_ + boff + ks * 32), b1 = *(const bf16x8*)(base_ + boff + 32 * LROW + ks * 32); \
            acc[0][0][0] = mfma(b0, a0, acc[0][0][0]); acc[0][0][1] = mfma(b0, a1, acc[0][0][1]); acc[1][0][0] = mfma(b0, a2, acc[1][0][0]); acc[1][0][1] = mfma(b0, a3, acc[1][0][1]); \
            acc[0][1][0] = mfma(b1, a0, acc[0][1][0]); acc[0][1][1] = mfma(b1, a1, acc[0][1][1]); acc[1][1][0] = mfma(b1, a2, acc[1][1][0]); acc[1][1][1] = mfma(b1, a3, acc[1][1][1]); } } while (0)
#define GWRITE_A(S, buf_) do { char* wb_ = lds + (buf_) * G2_STAGE + lw; \
        *(u32x4*)(wb_) = S##a0; *(u32x4*)(wb_ + 64 * LROW) = S##a1; *(u32x4*)(wb_ + 128 * LROW) = S##a2; *(u32x4*)(wb_ + 192 * LROW) = S##a3; } while (0)
#define GWRITE_B(S, buf_) do { char* wb_ = lds + (buf_) * G2_STAGE + lw; \
        *(u32x4*)(wb_ + 256 * LROW) = S##b0; *(u32x4*)(wb_ + 320 * LROW) = S##b1; *(u32x4*)(wb_ + 384 * LROW) = S##b2; *(u32x4*)(wb_ + 448 * LROW) = S##b3; } while (0)
#define GLOAD_A(S, kt_) do { const bf16_t* ap_ = Ag + ((kt_) << 6); \
        S##a0 = *(const u32x4*)(ap_); S##a1 = *(const u32x4*)(ap_ + a64); S##a2 = *(const u32x4*)(ap_ + 2 * a64); S##a3 = *(const u32x4*)(ap_ + 3 * a64); } while (0)
#define GLOAD_B(S, kt_) do { const bf16_t* bp_ = Bg + ((kt_) << 6); \
        S##b0 = *(const u32x4*)(bp_); S##b1 = *(const u32x4*)(bp_ + b64); S##b2 = *(const u32x4*)(bp_ + 2 * b64); S##b3 = *(const u32x4*)(bp_ + 3 * b64); } while (0)
#define GITER(kt_) do { GCOMP1(kt_, 0); __builtin_amdgcn_sched_barrier(0); if ((kt_) + 1 < KT) GWRITE_A(S0, ((kt_) + 1) & 1); \
        GCOMP1(kt_, 1); __builtin_amdgcn_sched_barrier(0); if ((kt_) + 1 < KT) GWRITE_B(S0, ((kt_) + 1) & 1); if ((kt_) + 2 < KT) GLOAD_A(S0, (kt_) + 2); \
        GCOMP1(kt_, 2); __builtin_amdgcn_sched_barrier(0); if ((kt_) + 2 < KT) GLOAD_B(S0, (kt_) + 2); \
        GCOMP1(kt_, 3); __syncthreads(); } while (0)
    GLOAD(S0, 0);
    GWRITE(S0, 0);
    if (KT > 1) GLOAD(S0, 1);
    __syncthreads();
    for (int kt = 0; kt < KT; ++kt) GITER(kt);
#undef GCOMP1
#undef GWRITE_A
#undef GWRITE_B
#undef GLOAD_A
#undef GLOAD_B
#undef GLOAD
#undef GWRITE
#undef GITER
    epi(acc[0], m0 + wm * 128, n0 + wn * 64, lane);
    epi(acc[1], m0 + wm * 128 + 64, n0 + wn * 64, lane);
}
DI void tile_mn(int t, int MT, int NT, int& mt, int& nt) {
    const int per = 8 * NT, g = t / per, r = t - g * per, gm = (MT - g * 8) < 8 ? (MT - g * 8) : 8;
    nt = r / gm; mt = g * 8 + (r - nt * gm);
}

struct EpiIn {
    char* ws; float* ssq; const float2* T; bool do_ssq;
    DI void operator()(f32x16 (&acc)[2][2], int mbase, int nbase, int lane) const {
        const int l31 = lane & 31, h = lane >> 5;
        bf16_t* QA = (bf16_t*)(ws + OFF_QA); bf16_t* KA = (bf16_t*)(ws + OFF_KA); bf16_t* VTA = (bf16_t*)(ws + OFF_VTA);
        bf16_t* QB = (bf16_t*)(ws + OFF_QB); bf16_t* KB = (bf16_t*)(ws + OFF_KB); bf16_t* VTB = (bf16_t*)(ws + OFF_VTB);
        bf16_t* KC = (bf16_t*)(ws + OFF_KC); bf16_t* CQ = (bf16_t*)(ws + OFF_CQ); bf16_t* CKV = (bf16_t*)(ws + OFF_CKV);
#pragma unroll
        for (int mt = 0; mt < 2; ++mt) {
            const int r = mbase + mt * 32 + l31;
            const RowInfo ri = rowinfo(r);
            const size_t sp = ri.sp; const int spp = perm16(ri.sp);
#pragma unroll
            for (int nt = 0; nt < 2; ++nt) {
                const int g = (nbase + nt * 32) >> 5;
                f32x16 v = acc[nt][mt];
                if (g < 16) {
                    const int half = g & 1;
                    if (ri.lat) rope_a(v, T, half ? ri.pcol : ri.prow, h);
                    if (g < 12) store16_bf(QA + ((size_t)(ri.b * 6 + (g >> 1)) * SP + sp) * 64 + half * 32, v, h, 0.125f * LOG2E);
                    else        store16_bf(KA + ((size_t)(ri.b * 2 + ((g - 12) >> 1)) * SP + sp) * 64 + half * 32, v, h, 1.f);
                } else if (g < 20) {
                    const int j = g - 16;
                    store16_vt(VTA + ((size_t)(ri.b * 2 + (j >> 1)) * 64 + (j & 1) * 32) * SP, v, h, 1.f, spp);
                } else if (g < 36) {
                    if (ri.lat) rope_b(v, T, ri.prow, ri.pcol, h);
                    if (g < 28) { const int j = g - 20; store16_bf(QB + ((size_t)(ri.b * 4 + (j >> 1)) * SP + sp) * 64 + (j & 1) * 32, v, h, 0.17677669529663687f * LOG2E); }
                    else        { const int j = g - 28; store16_bf(KB + ((size_t)(ri.b * 4 + (j >> 1)) * SP + sp) * 64 + (j & 1) * 32, v, h, 1.f); }
                } else if (g < 44) {
                    const int j = g - 36;
                    store16_vt(VTB + ((size_t)(ri.b * 4 + (j >> 1)) * 64 + (j & 1) * 32) * SP, v, h, 1.f, spp);
                } else if (g < 56) {
                    float s = 0.f;
#pragma unroll
                    for (int i = 0; i < 16; ++i) s += v[i] * v[i];
                    s += __shfl_xor(s, 32);
                    if (g < 52) { store16_bf(CQ + (size_t)r * 256 + (g - 44) * 32, v, h, 1.f); if (h == 0 && do_ssq) atomicAdd(ssq + (size_t)r * 2, s); }
                    else        { store16_bf(CKV + (size_t)r * 128 + (g - 52) * 32, v, h, 1.f); if (h == 0 && do_ssq) atomicAdd(ssq + (size_t)r * 2 + 1, s); }
                } else if (g == 56) {
                    if (ri.lat) rope_b(v, T, ri.prow, ri.pcol, h);
#pragma unroll
                    for (int hh = 0; hh < 6; ++hh) store16_bf(KC + ((size_t)(ri.b * 6 + hh) * SP + sp) * 96 + 64, v, h, 1.f);
                }
            }
        }
    }
};

struct EpiQup {
    char* ws; const float* ssq; const float2* T;
    DI void operator()(f32x16 (&acc)[2][2], int mbase, int nbase, int lane) const {
        const int l31 = lane & 31, h = lane >> 5;
        bf16_t* QC = (bf16_t*)(ws + OFF_QC);
#pragma unroll
        for (int mt = 0; mt < 2; ++mt) {
            const int r = mbase + mt * 32 + l31;
            const RowInfo ri = rowinfo(r);
            const float rstd = rsqrtf(ssq[(size_t)r * 2] * (1.f / 256.f) + EPS) * (0.10206207261596575f * LOG2E);
#pragma unroll
            for (int nt = 0; nt < 2; ++nt) {
                const int g = (nbase + nt * 32) >> 5;
                if (g >= 18) continue;
                f32x16 v = acc[nt][mt];
                const int head = g / 3, part = g - head * 3;
                if (part == 2 && ri.lat) rope_b(v, T, ri.prow, ri.pcol, h);
                store16_bf(QC + ((size_t)(ri.b * 6 + head) * SP + ri.sp) * 96 + part * 32, v, h, rstd);
            }
        }
    }
};
struct EpiKvup {
    char* ws; const float* ssq;
    DI void operator()(f32x16 (&acc)[2][2], int mbase, int nbase, int lane) const {
        const int l31 = lane & 31, h = lane >> 5;
        bf16_t* KC = (bf16_t*)(ws + OFF_KC); bf16_t* VTC = (bf16_t*)(ws + OFF_VTC);
#pragma unroll
        for (int mt = 0; mt < 2; ++mt) {
            const int r = mbase + mt * 32 + l31;
            const RowInfo ri = rowinfo(r);
            const float rstd = rsqrtf(ssq[(size_t)r * 2 + 1] * (1.f / 128.f) + EPS);
            const int spp = perm16(ri.sp);
#pragma unroll
            for (int nt = 0; nt < 2; ++nt) {
                const int g = (nbase + nt * 32) >> 5;
                const f32x16 v = acc[nt][mt];
                if (g < 12) store16_bf(KC + ((size_t)(ri.b * 6 + (g >> 1)) * SP + ri.sp) * 96 + (g & 1) * 32, v, h, rstd);
                else { const int j = g - 12; store16_vt(VTC + ((size_t)(ri.b * 6 + (j >> 1)) * 64 + (j & 1) * 32) * SP, v, h, rstd, spp); }
            }
        }
    }
};
struct EpiF32 {
    bf16_t* O;
    DI void operator()(f32x16 (&acc)[2][2], int mbase, int nbase, int lane) const {
        const int l31 = lane & 31, h = lane >> 5;
#pragma unroll
        for (int mt = 0; mt < 2; ++mt) {
            bf16_t* rowp = O + (size_t)(mbase + mt * 32 + l31) * DM + nbase;
#pragma unroll
            for (int nt = 0; nt < 2; ++nt) store16_bf(rowp + nt * 32, acc[nt][mt], h, 1.f);
        }
    }
};
struct EpiGU {
    bf16_t* G;
    DI void operator()(f32x16 (&acc)[2][2], int mbase, int nbase, int lane) const {
        const int l31 = lane & 31, h = lane >> 5;
#pragma unroll
        for (int mt = 0; mt < 2; ++mt) {
            bf16_t* rowp = G + (size_t)(mbase + mt * 32 + l31) * DFF + (nbase >> 1);
            f32x16 v;
#pragma unroll
            for (int i = 0; i < 16; ++i) v[i] = silu(acc[0][mt][i]) * acc[1][mt][i];
            store16_bf(rowp, v, h, 1.f);
        }
    }
};

DI int imax3(int a, int b, int c) { return max(max(a, b), c); }
template <int KW, int DKQ>
DI void attn_tile(const char* kb, const char* vb, const bf16x8 (&qf)[DKQ / 16], int koff, bool domask, int kq0, bool first,
                  f32x16 (&o)[2], float& mref, float& l, int l31, int h) {
    constexpr int KROW = (KW + 8) * 2, NQ = DKQ / 16;
    f32x16 s0, s1;
    bf16x8 kf0[NQ], kf1[NQ];
#pragma unroll
    for (int st = 0; st < NQ; ++st) {
        kf0[st] = *(const bf16x8*)(kb + l31 * KROW + (koff + st * 16 + h * 8) * 2);
        kf1[st] = *(const bf16x8*)(kb + (32 + l31) * KROW + (koff + st * 16 + h * 8) * 2);
    }
    const float nm = -mref;
#pragma unroll
    for (int e = 0; e < 16; ++e) { s0[e] = nm; s1[e] = nm; }
    __builtin_amdgcn_sched_barrier(0);
#pragma unroll
    for (int st = 0; st < NQ; ++st) { s0 = mfma(kf0[st], qf[st], s0); s1 = mfma(kf1[st], qf[st], s1); }
    bf16x8 vf[2][4];
#pragma unroll
    for (int db = 0; db < 2; ++db)
#pragma unroll
        for (int kk = 0; kk < 4; ++kk) vf[db][kk] = *(const bf16x8*)(vb + (db * 32 + l31) * LROW + (kk * 16 + h * 8) * 2);
    __builtin_amdgcn_sched_barrier(0);
    if (domask) {
#pragma unroll
        for (int i = 0; i < 16; ++i) {
            const int d0 = kq0 + crow(i, h), d1 = d0 + 32;
            s0[i] = (d0 > 128 || d0 < -128) ? -1e30f : s0[i];
            s1[i] = (d1 > 128 || d1 < -128) ? -1e30f : s1[i];
        }
    }
    int mi = imax3(__float_as_int(s0[0]), __float_as_int(s0[1]), __float_as_int(s1[0]));
    mi = max(mi, __float_as_int(s1[1]));
#pragma unroll
    for (int i = 2; i < 16; i += 2) { mi = imax3(mi, __float_as_int(s0[i]), __float_as_int(s0[i + 1])); mi = imax3(mi, __float_as_int(s1[i]), __float_as_int(s1[i + 1])); }
    mi = max(mi, __shfl_xor(mi, 32));
    if (__any(first || mi > 0x41000000)) {
        float mx = fmaxf(s0[0], s1[0]);
#pragma unroll
        for (int i = 1; i < 16; ++i) mx = fmaxf(mx, fmaxf(s0[i], s1[i]));
        mx = fmaxf(mx, __shfl_xor(mx, 32));
        const float d = first ? mx : fmaxf(mx, 0.f);
        mref += d;
        const float alpha = first ? 1.f : __builtin_amdgcn_exp2f(-d);
        l *= alpha;
#pragma unroll
        for (int e = 0; e < 16; ++e) { o[0][e] *= alpha; o[1][e] *= alpha; s0[e] -= d; s1[e] -= d; }
    }
    float ps0 = 0.f, ps1 = 0.f;
#pragma unroll
    for (int i = 0; i < 16; ++i) { s0[i] = __builtin_amdgcn_exp2f(s0[i]); s1[i] = __builtin_amdgcn_exp2f(s1[i]); ps0 += s0[i]; ps1 += s1[i]; }
    l += ps0 + ps1;
    bf16x8 pf[4];
    pf[0] = pack8(s0, 0); pf[1] = pack8(s0, 1); pf[2] = pack8(s1, 0); pf[3] = pack8(s1, 1);
#pragma unroll
    for (int db = 0; db < 2; ++db)
#pragma unroll
        for (int kk = 0; kk < 4; ++kk) o[db] = mfma(vf[db][kk], pf[kk], o[db]);
}

template <int KW, int DKQ>
DI void attn_loop(const bf16_t* __restrict__ Qg, const bf16_t* __restrict__ Kg, const bf16_t* __restrict__ Vg, int qrow, int koff,
                  int r0a, int n0, int r1a, int n1, bool mask, int qpos, bool has_ref, char* lds, f32x16 (&o)[2], float& mref, float& l, const int tid) {
    constexpr int KROW = (KW + 8) * 2, KT_BYTES = 64 * KROW, VT_BYTES = 64 * LROW, STAGE = KT_BYTES + VT_BYTES, NKC = KW / 8, NQ = DKQ / 16;
    constexpr bool K2 = (64 * NKC) > 512;
    const int lane = tid & 63, l31 = lane & 31, h = lane >> 5;
    bf16x8 qf[NQ];
#pragma unroll
    for (int st = 0; st < NQ; ++st) qf[st] = *(const bf16x8*)(Qg + (size_t)(qrow + l31) * KW + koff + st * 16 + h * 8);
    const int c0 = tid, row0 = c0 / NKC, kc0 = c0 - row0 * NKC, kgo0 = row0 * KW + kc0 * 8, klo0 = row0 * KROW + kc0 * 16;
    const int c1 = tid + 512, row1 = c1 / NKC, kc1 = c1 - row1 * NKC, kgo1 = row1 * KW + kc1 * 8, klo1 = row1 * KROW + kc1 * 16;
    const bool has2 = K2 && tid < 64 * NKC - 512;
    const int vrow = tid >> 3, vkc = tid & 7;
    const bf16_t* Vg0 = Vg + (size_t)vrow * SP + vkc * 8;
    const int vlo = KT_BYTES + vrow * LROW + vkc * 16;
    u32x4 Ak0, Ak1 = {0u, 0u, 0u, 0u}, Av0, Bk0, Bk1 = {0u, 0u, 0u, 0u}, Bv0;
    const int NT = n0 + n1;
#define AKEY(t_) ((t_) < n0 ? r0a + 64 * (t_) : r1a + 64 * ((t_) - n0))
#define ALOAD(S, key0_) do { const bf16_t* kp_ = Kg + (size_t)(key0_) * KW; S##k0 = *(const u32x4*)(kp_ + kgo0); if (K2) { if (has2) S##k1 = *(const u32x4*)(kp_ + kgo1); } \
        S##v0 = *(const u32x4*)(Vg0 + (key0_)); } while (0)
#define AWRITE(S, wb_) do { *(u32x4*)((wb_) + klo0) = S##k0; if (K2) { if (has2) *(u32x4*)((wb_) + klo1) = S##k1; } *(u32x4*)((wb_) + vlo) = S##v0; } while (0)
#define AITER(t_, SL, SW) do { const int key0_t = AKEY(t_); if ((t_) + 2 < NT) { const int kn_ = AKEY((t_) + 2); ALOAD(SL, kn_); } \
        const char* kb_ = lds + ((t_) & 1) * STAGE; \
        attn_tile<KW, DKQ>(kb_, kb_ + KT_BYTES, qf, koff, mask && key0_t < SEQ, key0_t - qpos, (t_) == 0 && !has_ref, o, mref, l, l31, h); \
        if ((t_) + 1 < NT) { char* wb_ = lds + (((t_) + 1) & 1) * STAGE; AWRITE(SW, wb_); } __syncthreads(); } while (0)
    { const int k0_ = AKEY(0); ALOAD(A, k0_); }
    if (NT > 1) { const int k1_ = AKEY(1); ALOAD(B, k1_); }
    AWRITE(A, lds);
    __syncthreads();
    int t = 0;
    for (; t + 2 <= NT; t += 2) { AITER(t, A, B); AITER(t + 1, B, A); }
    if (t < NT) AITER(t, A, B);
#undef AKEY
#undef ALOAD
#undef AWRITE
#undef AITER
}

DI void zero_o(f32x16 (&o)[2]) {
#pragma unroll
    for (int e = 0; e < 16; ++e) { o[0][e] = 0.f; o[1][e] = 0.f; }
}
DI void store_o(bf16_t* dst, const f32x16 (&o)[2], int h, float inv) { store16_bf(dst, o[0], h, inv); store16_bf(dst + 32, o[1], h, inv); }

constexpr int U_C = 384, U_B = 512, U_A = 384, U_LAT = U_C + U_B + U_A, U_CC = 12, U_BC = 16, U_AC = 12;
#ifndef ATT_MASK
#define ATT_MASK 7
#endif
#define RELANE() int tid2 = threadIdx.x; asm volatile("" : "+v"(tid2)); const int lane = tid2 & 63, wid = tid2 >> 6, l31 = lane & 31, h = lane >> 5; (void)wid; (void)l31; (void)h
DI void attn_unit(const Params& p, char* ws, int layer, int u, char* lds, const int tid) {
    bf16_t* OCAT = (bf16_t*)(ws + OFF_H);
    int type, b, head, qrow_blk, ctxq = 0;
    if (u < U_C) { type = 2; b = u / 192; const int r = u % 192; head = r >> 5; qrow_blk = (r & 31) * 256; }
    else if (u < U_C + U_B) { const int v = u - U_C; type = 1; b = v >> 8; const int r = v & 255; head = r >> 6; qrow_blk = (r & 63) * 128; }
    else if (u < U_LAT) { const int v = u - U_C - U_B; type = 0; b = v / 192; const int r = v % 192; head = r >> 5; qrow_blk = (r & 31) * 256; }
    else if (u < U_LAT + U_CC) { const int v = u - U_LAT; type = 2; ctxq = 1; b = v / 6; head = v % 6; qrow_blk = SEQ; }
    else if (u < U_LAT + U_CC + U_BC) { const int v = u - U_LAT - U_CC; type = 1; ctxq = 1; b = v >> 3; const int r = v & 7; head = r >> 1; qrow_blk = SEQ + (r & 1) * 128; }
    else { const int v = u - U_LAT - U_CC - U_BC; type = 0; ctxq = 1; b = v / 6; head = v % 6; qrow_blk = SEQ; }

    if (type == 1) { if (ATT_MASK & 2) {
        f32x16 o[2]; zero_o(o);
        float m = 0.f, l = 0.f;
        const bf16_t* Qg = (const bf16_t*)(ws + OFF_QB) + (size_t)(b * 4 + head) * SP * 64;
        const bf16_t* Kg = (const bf16_t*)(ws + OFF_KB) + (size_t)(b * 4 + head) * SP * 64;
        const bf16_t* Vg = (const bf16_t*)(ws + OFF_VTB) + (size_t)(b * 4 + head) * 64 * SP;
        attn_loop<64, 32>(Qg, Kg, Vg, qrow_blk + ((tid >> 6) & 3) * 32, (tid >> 8) * 32, ctxq ? SEQ : 0, ctxq ? 4 : SP / 64, 0, 0, false, 0, false, lds, o, m, l, tid);
        RELANE();
        const float lt = l + __shfl_xor(l, 32), inv = 1.f / lt;
        float* xb = (float*)lds;
        if (wid >= 4) {
#pragma unroll
            for (int db = 0; db < 2; ++db)
#pragma unroll
                for (int i = 0; i < 16; ++i) xb[((wid - 4) * 32 + db * 16 + i) * 64 + lane] = o[db][i] * inv;
        }
        __syncthreads();
        if (wid < 4) {
            const float lam = ((const float*)(ws + OFF_LAM))[layer];
            const float lam_init = layer == 0 ? 0.2f : 0.35550906759096926f;
            float ss = 0.f;
#pragma unroll
            for (int db = 0; db < 2; ++db)
#pragma unroll
                for (int i = 0; i < 16; ++i) { const float v = o[db][i] * inv - lam * xb[(wid * 32 + db * 16 + i) * 64 + lane]; o[db][i] = v; ss += v * v; }
            ss += __shfl_xor(ss, 32);
            const float rstd = rsqrtf(ss * (1.f / 64.f) + EPS) * (1.f - lam_init);
            const float* gs = p.sub_norm + layer * 64;
#pragma unroll
            for (int db = 0; db < 2; ++db)
#pragma unroll
                for (int i = 0; i < 16; ++i) o[db][i] *= gs[db * 32 + crow(i, h)];
            const int qi = qrow_blk + wid * 32 + l31;
            const size_t orow = ctxq ? (size_t)(NLAT + b * CTXL + (qi - SEQ)) : (size_t)(b * SEQ + qi);
            store_o(OCAT + orow * DM + 384 + head * 64, o, h, rstd);
        }
        __syncthreads(); }
    } else if (type == 2) { if (ATT_MASK & 4) {
        f32x16 o[2]; zero_o(o);
        float m = 0.f, l = 0.f;
        const bf16_t* Qg = (const bf16_t*)(ws + OFF_QC) + (size_t)(b * 6 + head) * SP * 96;
        const bf16_t* Kg = (const bf16_t*)(ws + OFF_KC) + (size_t)(b * 6 + head) * SP * 96;
        const bf16_t* Vg = (const bf16_t*)(ws + OFF_VTC) + (size_t)(b * 6 + head) * 64 * SP;
        attn_loop<96, 96>(Qg, Kg, Vg, qrow_blk + (tid >> 6) * 32, 0, ctxq ? SEQ : 0, ctxq ? 4 : SP / 64, 0, 0, false, 0, false, lds, o, m, l, tid);
        RELANE();
        const int qi = qrow_blk + wid * 32 + l31;
        const size_t orow = ctxq ? (size_t)(NLAT + b * CTXL + (qi - SEQ)) : (size_t)(b * SEQ + qi);
        const float lt = l + __shfl_xor(l, 32), inv = 1.f / lt;
        store_o(OCAT + orow * DM + 640 + head * 64, o, h, inv); }
    } else if (ATT_MASK & 1) {
        f32x16 o[2]; zero_o(o);
        const int kvh = head / 3;
        const bf16_t* Qg = (const bf16_t*)(ws + OFF_QA) + (size_t)(b * 6 + head) * SP * 64;
        const bf16_t* Kg = (const bf16_t*)(ws + OFF_KA) + (size_t)(b * 2 + kvh) * SP * 64;
        const bf16_t* Vg = (const bf16_t*)(ws + OFF_VTA) + (size_t)(b * 2 + kvh) * 64 * SP;
        float m = p.win_sink[layer * 6 + head] * LOG2E, l = (tid & 32) ? 0.f : 1.f;
        const int qb = qrow_blk >> 7, lo = (qb > 0 ? qb - 1 : 0) * 128, hi = (qb + 3 < 64 ? qb + 3 : 64) * 128;
        attn_loop<64, 64>(Qg, Kg, Vg, qrow_blk + (tid >> 6) * 32, 0, ctxq ? SEQ : lo, ctxq ? 4 : (hi - lo) >> 6, SEQ, ctxq ? 0 : 4, !ctxq, qrow_blk + (tid >> 6) * 32 + (tid & 31), true, lds, o, m, l, tid);
        RELANE();
        const int qi = qrow_blk + wid * 32 + l31;
        const size_t orow = ctxq ? (size_t)(NLAT + b * CTXL + (qi - SEQ)) : (size_t)(b * SEQ + qi);
        const float lt = l + __shfl_xor(l, 32), inv = 1.f / lt;
        store_o(OCAT + orow * DM + head * 64, o, h, inv);
    }
}

DI float wave_sum(float v) {
#pragma unroll
    for (int o = 32; o > 0; o >>= 1) v += __shfl_xor(v, o);
    return v;
}
typedef float f32x4n __attribute__((ext_vector_type(4)));
typedef unsigned u32x2n __attribute__((ext_vector_type(2)));
DI void load_row(const float* p, int lane, float4 (&v)[4]) {
#pragma unroll
    for (int j = 0; j < 4; ++j) { const f32x4n t = __builtin_nontemporal_load((const f32x4n*)(p + j * 256 + lane * 4)); v[j] = make_float4(t[0], t[1], t[2], t[3]); }
}
DI void load_row_bf(const bf16_t* p, int lane, float4 (&v)[4]) {
#pragma unroll
    for (int j = 0; j < 4; ++j) { const u32x2n wq = __builtin_nontemporal_load((const u32x2n*)(p + j * 256 + lane * 4)); const uint2 w = make_uint2(wq[0], wq[1]);
        v[j] = make_float4(__uint_as_float(w.x << 16), __uint_as_float(w.x & 0xffff0000u), __uint_as_float(w.y << 16), __uint_as_float(w.y & 0xffff0000u)); }
}
DI void load_row_part(const bf16_t* p, int lane, float4 (&v)[4]) {
    load_row_bf(p, lane, v);
#pragma unroll
    for (int q = 1; q < 4; ++q) { float4 t[4]; load_row_bf(p + (size_t)q * 512 * DM, lane, t);
#pragma unroll
        for (int j = 0; j < 4; ++j) { v[j].x += t[j].x; v[j].y += t[j].y; v[j].z += t[j].z; v[j].w += t[j].w; } }
}
DI float ssq_row(const float4 (&v)[4]) {
    float s = 0.f;
#pragma unroll
    for (int j = 0; j < 4; ++j) s += v[j].x * v[j].x + v[j].y * v[j].y + v[j].z * v[j].z + v[j].w * v[j].w;
    return wave_sum(s);
}
DI void norm_mod_store(const float4 (&x)[4], const float* g, const float* sh, const float* sc, bf16_t* dst, int lane) {
    const float rstd = rsqrtf(ssq_row(x) * (1.f / DM) + EPS);
#pragma unroll
    for (int j = 0; j < 4; ++j) {
        const int c = j * 256 + lane * 4;
        const float4 gg = *(const float4*)(g + c), s1 = *(const float4*)(sc + c), s0 = *(const float4*)(sh + c);
        st4(dst + c, x[j].x * rstd * gg.x * (1.f + s1.x) + s0.x, x[j].y * rstd * gg.y * (1.f + s1.y) + s0.y,
            x[j].z * rstd * gg.z * (1.f + s1.z) + s0.z, x[j].w * rstd * gg.w * (1.f + s1.w) + s0.w);
    }
}
DI void resid_add(float4 (&x)[4], const float4 (&y)[4], const float* g, const float* gt, int lane) {
    const float rstd = rsqrtf(ssq_row(y) * (1.f / DM) + EPS);
#pragma unroll
    for (int j = 0; j < 4; ++j) {
        const int c = j * 256 + lane * 4;
        const float4 gg = *(const float4*)(g + c), t = *(const float4*)(gt + c);
        x[j].x += t.x * (y[j].x * rstd * gg.x); x[j].y += t.y * (y[j].y * rstd * gg.y);
        x[j].z += t.z * (y[j].z * rstd * gg.z); x[j].w += t.w * (y[j].w * rstd * gg.w);
    }
}
DI void store_row(float* p, int lane, const float4 (&v)[4]) {
#pragma unroll
    for (int j = 0; j < 4; ++j) *(float4*)(p + j * 256 + lane * 4) = v[j];
}
DI const float* modp(const Params& p, int layer, int r) { const int v = r < NLAT ? (r >> 13) : 2; return (const float*)(p.ws + OFF_MOD) + (size_t)(layer * 3 + v) * 6144; }
DI float* xrow(const Params& p, int r) { return r < NLAT ? p.out + (size_t)r * DM : (float*)(p.ws + OFF_XCTX) + (size_t)(r - NLAT) * DM; }
DI const float* xin_row(const Params& p, int r) { return r < NLAT ? p.x + (size_t)r * DM : p.ctx + (size_t)(r - NLAT) * DM; }

DI void convT_task(const float* __restrict__ W0, const float* __restrict__ W1, int Nsrc, int K, int mid, const float* kscale, bf16_t* Bt, int tn, int tk, char* lds, const int tid) {
    float* tile = (float*)lds;
    const int tx = tid & 63, ty = tid >> 6;
    const int n = tn * 64 + tx;
    int src; const float* W = W0;
    switch (mid) {
        case 0: src = n < 640 ? n : (n < 1152 ? (n & ~31) + perm32(n & 31) : (n < 1792 ? n : (n < 1824 ? 1792 + perm32(n - 1792) : -1))); break;
        case 2: { const int q = n >> 6, t = (n >> 5) & 1, j = n & 31; src = q * 32 + j; W = t ? W1 : W0; } break;
        case 4: { if (n < 576) { const int hd = n / 96, w = n - hd * 96; src = hd * 96 + (w < 64 ? w : 64 + perm32(w - 64)); } else src = -1; } break;
        case 5: { if (n < 384) src = (n >> 6) * 128 + (n & 63); else { const int v = n - 384; src = (v >> 6) * 128 + 64 + (v & 63); } } break;
        default: src = n; break;
    }
    const int k0 = tk * 64;
    float vv[16];
#pragma unroll
    for (int i = 0; i < 16; ++i) { const int kk = ty + 4 * i; vv[i] = src >= 0 ? __builtin_nontemporal_load(&W[(size_t)(k0 + kk) * Nsrc + src]) : 0.f; }
#pragma unroll
    for (int i = 0; i < 16; ++i) { const int kk = ty + 4 * i; float v = vv[i]; if (kscale) v *= kscale[k0 + kk]; tile[kk * 65 + tx] = v; }
    __syncthreads();
    const int kp = tid & 31, nn0 = tid >> 5;
#pragma unroll
    for (int it = 0; it < 8; ++it) {
        const int nn = nn0 + 8 * it;
        *(unsigned*)(Bt + (size_t)(tn * 64 + nn) * K + k0 + 2 * kp) = pk2(tile[(2 * kp) * 65 + nn], tile[(2 * kp + 1) * 65 + nn]);
    }
    __syncthreads();
}
DI void ada_task(const Params& p, int layer, int jb, char* lds, const int tid) {
    float* sv = (float*)lds;
    float* red = sv + 3 * 1024;
    for (int i = tid; i < 3 * 1024; i += 256) { const int v = i >> 10, k = i & 1023; const float c = v < 2 ? p.c[v * 1024 + k] : p.c_ctx[k]; sv[i] = c / (1.f + __expf(-c)); }
    __syncthreads();
    const int kq = tid >> 3, c4 = (tid & 7) * 4;
    const float* W = p.w_ada + (size_t)layer * 1024 * 6144 + jb * 32 + c4;
    float acc[3][4];
#pragma unroll
    for (int v = 0; v < 3; ++v)
#pragma unroll
        for (int c = 0; c < 4; ++c) acc[v][c] = 0.f;
#pragma unroll
    for (int hb = 0; hb < 2; ++hb) {
        f32x4n wv[16];
#pragma unroll
        for (int i = 0; i < 16; ++i) wv[i] = __builtin_nontemporal_load((const f32x4n*)(W + (size_t)(kq + 32 * (hb * 16 + i)) * 6144));
#pragma unroll
        for (int i = 0; i < 16; ++i) { const int k = kq + 32 * (hb * 16 + i);
#pragma unroll
            for (int v = 0; v < 3; ++v) { const float sk = sv[v * 1024 + k];
#pragma unroll
                for (int c = 0; c < 4; ++c) acc[v][c] += sk * wv[i][c]; } }
    }
#pragma unroll
    for (int v = 0; v < 3; ++v)
#pragma unroll
        for (int c = 0; c < 4; ++c) red[(kq * 3 + v) * 32 + c4 + c] = acc[v][c];
    __syncthreads();
    if (tid < 96) {
        const int v = tid >> 5, jj = tid & 31, j = jb * 32 + jj;
        float sacc = 0.f;
#pragma unroll
        for (int q = 0; q < 32; ++q) sacc += red[(q * 3 + v) * 32 + jj];
        ((float*)(p.ws + OFF_MOD))[(size_t)(layer * 3 + v) * 6144 + j] = sacc + p.b_ada[layer * 6144 + j];
    }
    __syncthreads();
}

constexpr int T_ADA = 384;
constexpr int T_IN = 32 * 16, T_OUT = 16 * 16, T_GU = 88 * 16, T_DN = 16 * 44, T_QUP = 12 * 4, T_KVUP = 12 * 2;
constexpr int T_CONV_L = T_IN + T_OUT + T_GU + T_DN + T_QUP + T_KVUP;
constexpr int T_PREP = T_ADA + 2 * T_CONV_L;

DI void phase_prep(const Params& p, char* ws, char* lds, const int tid, const int VB, const int VG) {
    {
        float* ssq = (float*)(ws + OFF_SSQ);
        for (size_t i = (size_t)VB * 256 + tid; i < (size_t)2 * NROW * 2; i += (size_t)VG * 256) ssq[i] = 0.f;
        if (VB == 0 && tid < 64) ((unsigned*)(ws + OFF_CTR))[tid] = 0u;
        if (VB == VG - 1) {
            float2* T = (float2*)(ws + OFF_ROPE);
            for (int i = tid; i < 128 * 16; i += 256) { const int pos = i >> 4, f = i & 15; const float fr = powf(10000.f, -(float)f / 16.f); float sn, cs; sincosf((float)pos * fr, &sn, &cs); T[i] = make_float2(cs, sn); }
            if (tid < 2) {
                float d1 = 0.f, d2 = 0.f;
                for (int k = 0; k < 32; ++k) { d1 += p.lq1[tid * 32 + k] * p.lk1[tid * 32 + k]; d2 += p.lq2[tid * 32 + k] * p.lk2[tid * 32 + k]; }
                const float lam_init = tid == 0 ? 0.2f : 0.35550906759096926f;
                ((float*)(ws + OFF_LAM))[tid] = expf(d1) - expf(d2) + lam_init;
            }
        }
    }
    for (int t = VB; t < T_PREP; t += VG) {
        if (t < T_ADA) { ada_task(p, t / 192, t % 192, lds, tid); continue; }
        int u = t - T_ADA;
        const int layer = u / T_CONV_L; u -= layer * T_CONV_L;
        if (u < T_IN) { convT_task(p.w_in + (size_t)layer * DM * 1824, nullptr, 1824, DM, 0, nullptr, (bf16_t*)(ws + OFF_BT_IN + layer * SZ_BT_IN), u >> 4, u & 15, lds, tid); continue; }
        u -= T_IN;
        if (u < T_OUT) { convT_task(p.w_out + (size_t)layer * DM * DM, nullptr, DM, DM, 1, nullptr, (bf16_t*)(ws + OFF_BT_OUT + layer * SZ_BT_OUT), u >> 4, u & 15, lds, tid); continue; }
        u -= T_OUT;
        if (u < T_GU) { convT_task(p.w_gate + (size_t)layer * DM * DFF, p.w_up + (size_t)layer * DM * DFF, DFF, DM, 2, nullptr, (bf16_t*)(ws + OFF_BT_GU + layer * SZ_BT_GU), u >> 4, u & 15, lds, tid); continue; }
        u -= T_GU;
        if (u < T_DN) { convT_task(p.w_down + (size_t)layer * DFF * DM, nullptr, DM, DFF, 3, nullptr, (bf16_t*)(ws + OFF_BT_DN + layer * SZ_BT_DN), u / 44, u % 44, lds, tid); continue; }
        u -= T_DN;
        if (u < T_QUP) { convT_task(p.w_q_up + (size_t)layer * 256 * 576, nullptr, 576, 256, 4, p.q_norm + layer * 256, (bf16_t*)(ws + OFF_BT_QUP + layer * SZ_BT_QUP), u >> 2, u & 3, lds, tid); continue; }
        u -= T_QUP;
        convT_task(p.w_kv_up + (size_t)layer * 128 * 768, nullptr, 768, 128, 5, p.kv_norm + layer * 128, (bf16_t*)(ws + OFF_BT_KVUP + layer * SZ_BT_KVUP), u >> 1, u & 1, lds, tid);
    }
}

DI int attn_nt(int u) {
    if (u < U_C + U_B) return SP / 64;
    if (u < U_LAT) { const int qb = (u - U_C - U_B) & 63; return (qb == 0 || qb == 63) ? 8 : 10; }
    return 4;
}
__global__ void __launch_bounds__(512) fwd_mega(Params p) {
    __shared__ __attribute__((aligned(16))) char lds[LDS_BYTES];
    __shared__ int s_unit;
    __shared__ uint4 xb_words;
    cg::grid_group grid = cg::this_grid();
    if (threadIdx.x == 0) xb_words = make_uint4(0u, 0u, 0u, 0u);
    __syncthreads();
    const XcdBarrier xb = xcd_barrier_post((unsigned*)(p.ws + OFF_BAR), (volatile LAS unsigned*)&xb_words);
    for (int ph = p.ph_lo; ph < p.ph_hi; ++ph) {
        int tid5 = threadIdx.x; asm volatile("" : "+v"(tid5));
        size_t zoff = 0; asm volatile("" : "+s"(zoff));
        char* ws = p.ws + zoff;
        const int half = tid5 >> 8, tid = tid5 & 255, VB = blockIdx.x * 2 + half, VG = gridDim.x * 2;
        char* vlds = lds + half * HALF_LDS;
        const int lane = tid & 63, wid = tid >> 6;
        if (ph == 0) { if (PHON(0)) phase_prep(p, ws, vlds, tid, VB, VG); }
        else if (ph == 1 && PHON(1)) {
            bf16_t* H = (bf16_t*)(ws + OFF_H);
            for (int r = VB * 4 + wid; r < NROW; r += VG * 4) {
                float4 x[4]; load_row(xin_row(p, r), lane, x);
                const float* md = modp(p, 0, r);
                norm_mod_store(x, p.g_pre_mix, md, md + 1024, H + (size_t)r * DM, lane);
            }
        } else if (ph >= 2) {
            const int layer = (ph - 2) >> 3, sub = (ph - 2) & 7;
            const int MR = layer == 0 ? NROW : NLAT;
            if (sub == 0 && PHON(2)) {
                EpiIn epi{ws, (float*)(ws + OFF_SSQ) + (size_t)layer * NROW * 2, (const float2*)(ws + OFF_ROPE), true};
                const bf16_t* A = (const bf16_t*)(ws + OFF_H); const bf16_t* Bt = (const bf16_t*)(ws + OFF_BT_IN + layer * SZ_BT_IN);
                for (int t = blockIdx.x; t < (NROW / 256) * 7; t += gridDim.x) { int mt, nt; tile_mn(t, NROW / 256, 7, mt, nt); gemm256(A, DM, Bt, DM, DM, mt * 256, nt * 256, lds, epi, tid5); }
                for (int t = VG - 1 - VB; t < NROW / 128; t += VG) { int tt = threadIdx.x & 255; asm volatile("" : "+v"(tt)); gemm_tile(A, DM, Bt, DM, DM, t * 128, 1792, vlds, epi, tt); }
            } else if (sub == 1 && PHON(3)) {
                const float* ssq = (const float*)(ws + OFF_SSQ) + (size_t)layer * NROW * 2;
                EpiQup eq{ws, ssq, (const float2*)(ws + OFF_ROPE)}; EpiKvup ek{ws, ssq};
                const int nQ = (NROW / 256) * 3;
                for (int t = blockIdx.x; t < 2 * nQ; t += gridDim.x) {
                    if (t < nQ) { const int nt = t / (NROW / 256), mt = t - nt * (NROW / 256); gemm256((const bf16_t*)(ws + OFF_CQ), 256, (const bf16_t*)(ws + OFF_BT_QUP + layer * SZ_BT_QUP), 256, 256, mt * 256, nt * 256, lds, eq, tid5); }
                    else { const int v = t - nQ, nt = v / (NROW / 256), mt = v - nt * (NROW / 256); gemm256((const bf16_t*)(ws + OFF_CKV), 128, (const bf16_t*)(ws + OFF_BT_KVUP + layer * SZ_BT_KVUP), 128, 128, mt * 256, nt * 256, lds, ek, tid5); }
                }
            } else if (sub == 2 && PHON(4)) {
                unsigned* ctr = (unsigned*)(ws + OFF_CTR) + (layer * 2) * 8;
                const int qcount = layer == 0 ? 165 : 160;
                const int home = (int)(xb.x & 7u);
                for (int qq = 0; qq < 8; ++qq) {
                    const int q = (home + qq) & 7;
                    for (;;) {
                        if (threadIdx.x == 0) s_unit = (int)atomicAdd(ctr + q, 1u);
                        __syncthreads();
                        const int j = s_unit;
                        __syncthreads();
                        if (j >= qcount) break;
                        int u;
                        if (j < 16) u = (8 + (q >> 1)) * 32 + (q & 1) * 16 + j;
                        else if (j < 80) u = U_C + q * 64 + (j - 16);
                        else if (j < 112) u = q * 32 + (j - 80);
                        else if (j < 160) u = U_C + U_B + q * 48 + (j - 112);
                        else u = U_LAT + q * 5 + (j - 160);
                        int tid_u = threadIdx.x; asm volatile("" : "+v"(tid_u));
                        attn_unit(p, ws, layer, u, lds, tid_u);
                    }
                }
            } else if (sub == 3 && PHON(5)) {
                EpiF32 epi{(bf16_t*)(ws + OFF_MIX)};
                const bf16_t* A = (const bf16_t*)(ws + OFF_H); const bf16_t* Bt = (const bf16_t*)(ws + OFF_BT_OUT + layer * SZ_BT_OUT);
                for (int t = blockIdx.x; t < (NLAT / 256) * 4; t += gridDim.x) { int mt, nt; tile_mn(t, NLAT / 256, 4, mt, nt); gemm256(A, DM, Bt, DM, DM, mt * 256, nt * 256, lds, epi, tid5); }
                if (layer == 0)
                    for (int e = blockIdx.x; e < 32; e += gridDim.x) {
                        const int tl = e >> 2, q = e & 3;
                        EpiF32 ep{(bf16_t*)(ws + OFF_PART) + (size_t)q * 512 * DM - (size_t)NLAT * DM};
                        gemm256(A + q * (DM / 4), DM, Bt + q * (DM / 4), DM, DM / 4, (NLAT / 256 + (tl >> 2)) * 256, (tl & 3) * 256, lds, ep, tid5);
                    }
            } else if (sub == 4 && PHON(6)) {
                bf16_t* H = (bf16_t*)(ws + OFF_H); const bf16_t* MIX = (const bf16_t*)(ws + OFF_MIX);
                for (int r0 = VB * 4 + wid; r0 < MR; r0 += VG * 4) { const int r = MR - 1 - r0;
                    float4 x[4], y[4];
                    load_row(layer == 0 ? xin_row(p, r) : xrow(p, r), lane, x);
                    if (r >= NLAT) load_row_part((const bf16_t*)(ws + OFF_PART) + (size_t)(r - NLAT) * DM, lane, y); else load_row_bf(MIX + (size_t)r * DM, lane, y);
                    const float* md = modp(p, layer, r);
                    resid_add(x, y, p.g_post_mix + layer * DM, md + 2048, lane);
                    store_row(xrow(p, r), lane, x);
                    norm_mod_store(x, p.g_pre_ffn + layer * DM, md + 3072, md + 4096, H + (size_t)r * DM, lane);
                }
            } else if (sub == 5 && PHON(7)) {
                EpiGU epi{(bf16_t*)(ws + OFF_G)};
                const bf16_t* A = (const bf16_t*)(ws + OFF_H); const bf16_t* Bt = (const bf16_t*)(ws + OFF_BT_GU + layer * SZ_BT_GU);
                for (int t = blockIdx.x; t < (MR / 256) * 22; t += gridDim.x) { int mt, nt; tile_mn(t, MR / 256, 22, mt, nt); gemm256(A, DM, Bt, DM, DM, mt * 256, nt * 256, lds, epi, tid5); }
            } else if (sub == 6 && PHON(8)) {
                EpiF32 epi{(bf16_t*)(ws + OFF_MIX)};
                const bf16_t* A = (const bf16_t*)(ws + OFF_G); const bf16_t* Bt = (const bf16_t*)(ws + OFF_BT_DN + layer * SZ_BT_DN);
                for (int t = blockIdx.x; t < (NLAT / 256) * 4; t += gridDim.x) { int mt, nt; tile_mn(t, NLAT / 256, 4, mt, nt); mt = NLAT / 256 - 1 - mt; gemm256(A, DFF, Bt, DFF, DFF, mt * 256, nt * 256, lds, epi, tid5); }
                if (layer == 0)
                    for (int e = blockIdx.x; e < 32; e += gridDim.x) {
                        const int tl = e >> 2, q = e & 3;
                        EpiF32 ep{(bf16_t*)(ws + OFF_PART) + (size_t)q * 512 * DM - (size_t)NLAT * DM};
                        gemm256(A + q * (DFF / 4), DFF, Bt + q * (DFF / 4), DFF, DFF / 4, (NLAT / 256 + (tl >> 2)) * 256, (tl & 3) * 256, lds, ep, tid5);
                    }
            } else if (sub == 7 && PHON(9)) {
                bf16_t* H = (bf16_t*)(ws + OFF_H); const bf16_t* F = (const bf16_t*)(ws + OFF_MIX);
                for (int r0 = VB * 4 + wid; r0 < MR; r0 += VG * 4) { const int r = MR - 1 - r0;
                    float4 x[4], y[4];
                    load_row(xrow(p, r), lane, x);
                    if (r >= NLAT) load_row_part((const bf16_t*)(ws + OFF_PART) + (size_t)(r - NLAT) * DM, lane, y); else load_row_bf(F + (size_t)r * DM, lane, y);
                    const float* md = modp(p, layer, r);
                    resid_add(x, y, p.g_post_ffn + layer * DM, md + 5120, lane);
                    store_row(xrow(p, r), lane, x);
                    if (layer == 0) { const float* md1 = modp(p, 1, r); norm_mod_store(x, p.g_pre_mix + DM, md1, md1 + 1024, H + (size_t)r * DM, lane); }
                }
            }
        }
        if (ph + 1 < p.ph_hi) { if (ph < 0) grid.sync(); else xcd_barrier(xb); }
    }
}

extern "C" void kernel_launch(void* const* d_in, const int* in_sizes, int n_in, void* d_out, int out_size, void* d_ws, size_t ws_size, hipStream_t stream) {
    static int grid_blocks = 0;
    if (!grid_blocks) {
        int dev = 0, cus = 0, per_cu = 0;
        hipGetDevice(&dev);
        hipDeviceGetAttribute(&cus, hipDeviceAttributeMultiprocessorCount, dev);
        hipOccupancyMaxActiveBlocksPerMultiprocessor(&per_cu, fwd_mega, 512, 0);
        if (per_cu > 1) per_cu = 1;
        grid_blocks = cus * per_cu;
        if (ws_size < WS_NEED) fprintf(stderr, "kernel_launch: ws too small: %zu < %zu\n", ws_size, (size_t)WS_NEED);
    }
    Params p;
    memset(&p, 0, sizeof(p));
    const float* const* in = (const float* const*)d_in;
    p.x = in[0]; p.c = in[1]; p.ctx = in[2]; p.c_ctx = in[3]; p.w_ada = in[4]; p.b_ada = in[5]; p.g_pre_mix = in[6]; p.g_post_mix = in[7];
    p.w_in = in[8]; p.win_sink = in[9]; p.lq1 = in[10]; p.lk1 = in[11]; p.lq2 = in[12]; p.lk2 = in[13]; p.sub_norm = in[14];
    p.q_norm = in[15]; p.w_q_up = in[16]; p.kv_norm = in[17]; p.w_kv_up = in[18]; p.w_out = in[19]; p.g_pre_ffn = in[20]; p.g_post_ffn = in[21];
    p.w_gate = in[22]; p.w_up = in[23]; p.w_down = in[24];
    p.out = (float*)d_out; p.ws = (char*)d_ws; p.ph_lo = 0; p.ph_hi = NPHASE;
    (void)hipMemsetAsync((char*)d_ws + OFF_BAR, 0, XCD_BAR_WORDS * 4, stream);
    void* args[] = {&p};
    hipError_t e = hipLaunchCooperativeKernel((void*)fwd_mega, dim3(grid_blocks), dim3(512), args, 0, stream);
    if (e != hipSuccess) fprintf(stderr, "cooperative launch failed: %s (grid %d)\n", hipGetErrorString(e), grid_blocks);
}
```
